# Optimizing an MI355X kernel written in HIP

```python
import math
import jax, jax.numpy as jnp
from jax import lax
import numpy as np

D_MODEL = 2048
BATCH = 2
SEQ = 8192
DEPTH = 1

EPS = 1e-6
F_GROUPS = 4
F_GROUP_DIM = 256
F_WIDTH = F_GROUPS * F_GROUP_DIM
A_HEADS = 8
A_HEAD_DIM = D_MODEL // (2 * A_HEADS)
A_V_DIM = 2 * A_HEAD_DIM
A_QK_WIDTH = A_HEADS * 2 * A_HEAD_DIM
A_V_WIDTH = A_HEADS * A_V_DIM
Q_BLOCK = 128
IN_WIDTH = F_WIDTH + 2 * A_QK_WIDTH + A_V_WIDTH + 2 * D_MODEL
P_HEADS = 8
N_KEYS = 128
N_EXPERTS = N_KEYS * N_KEYS
P_KEY_DIM = 256
P_HALF = P_KEY_DIM // 2
P_TOPK = 16
P_TOKEN_BLOCK = 128

kernel_name = "hybrid_fnet_diffattn_peer_encoder"


def rmsnorm(x, g):
    xf = x.astype(jnp.float32)
    y = xf * lax.rsqrt(jnp.mean(xf * xf, axis=-1, keepdims=True) + EPS)
    return (y * g.astype(jnp.float32)).astype(x.dtype)


def alibi_slopes():
    return 2.0 ** (-8.0 * jnp.arange(1, A_HEADS + 1, dtype=jnp.float32) / A_HEADS)


def lambda_init_for(layer_idx):
    return 0.8 - 0.6 * math.exp(-0.3 * layer_idx)


def fourier_mix(z):
    B, S = z.shape[:2]
    zg = z.astype(jnp.float32).reshape(B, S, F_GROUPS, F_GROUP_DIM).transpose(0, 2, 1, 3)
    y = jnp.fft.fft2(zg, norm="ortho").real
    return y.transpose(0, 2, 1, 3).reshape(B, S, F_WIDTH).astype(z.dtype)


def diff_attention(q, k, v, lam, slopes):
    B, S = q.shape[:2]
    nb = S // Q_BLOCK
    qb = q.reshape(B, nb, Q_BLOCK, A_HEADS, 2, A_HEAD_DIM).swapaxes(0, 1)
    starts = jnp.arange(nb, dtype=jnp.int32) * Q_BLOCK
    kpos = jnp.arange(S, dtype=jnp.int32)
    scale = A_HEAD_DIM ** -0.5

    def block(args):
        qi, s0 = args
        qpos = s0 + jnp.arange(Q_BLOCK, dtype=jnp.int32)
        dist = jnp.abs(qpos[:, None] - kpos[None, :]).astype(jnp.float32)
        bias = -slopes[:, None, None] * dist
        s = jnp.einsum('bqhcd,bkhcd->bhcqk', qi, k,
                       preferred_element_type=jnp.float32) * scale + bias[None, :, None]
        p = jax.nn.softmax(s, axis=-1)
        a = p[:, :, 0] - lam * p[:, :, 1]
        return jnp.einsum('bhqk,bkhe->bqhe', a.astype(v.dtype), v)

    out = lax.map(block, (qb, starts))
    return out.swapaxes(0, 1).reshape(B, S, A_HEADS, A_V_DIM)


def peer(xn, w_query, sub_keys, expert_u, expert_v):
    B, S, D = xn.shape
    nb = (B * S) // P_TOKEN_BLOCK
    xb = xn.reshape(nb, P_TOKEN_BLOCK, D)
    t = P_TOKEN_BLOCK

    def block(xt):
        q = (xt @ w_query).reshape(t, P_HEADS, 2, P_HALF)
        s = jnp.einsum('thcd,hcnd->thcn', q, sub_keys,
                       preferred_element_type=jnp.float32)
        sv, si = lax.top_k(s, P_TOPK)
        cand = sv[:, :, 0, :, None] + sv[:, :, 1, None, :]
        cidx = si[:, :, 0, :, None] * N_KEYS + si[:, :, 1, None, :]
        top_s, top_j = lax.top_k(cand.reshape(t, P_HEADS, P_TOPK * P_TOPK), P_TOPK)
        idx = jnp.take_along_axis(cidx.reshape(t, P_HEADS, P_TOPK * P_TOPK), top_j, axis=-1)
        g = jax.nn.softmax(top_s, axis=-1)
        ue = jnp.take(expert_u, idx, axis=0)
        ve = jnp.take(expert_v, idx, axis=0)
        act = jax.nn.gelu(jnp.einsum('td,thkd->thk', xt, ue,
                                     preferred_element_type=jnp.float32), approximate=False) * g
        return jnp.einsum('thk,thkd->td', act.astype(ve.dtype), ve)

    return lax.map(block, xb).reshape(B, S, D)


def setup_inputs(seed: int = 0) -> dict:
    key = jax.random.key(seed)
    ks = jax.random.split(key, 20)
    f32 = jnp.float32

    def nrm(k, shape, scale):
        return jax.random.normal(k, shape, f32) * scale

    def gain(k, shape):
        return 1.0 + 0.02 * jax.random.normal(k, shape, f32)

    L = DEPTH
    return {
        "x": jax.random.normal(ks[0], (BATCH, SEQ, D_MODEL), f32),
        "norm1_g": gain(ks[1], (L, D_MODEL)),
        "w_in": nrm(ks[2], (L, D_MODEL, IN_WIDTH), D_MODEL ** -0.5),
        "w_fourier": nrm(ks[3], (L, F_WIDTH, D_MODEL), F_WIDTH ** -0.5),
        "w_attn": nrm(ks[4], (L, A_V_WIDTH, D_MODEL), A_V_WIDTH ** -0.5),
        "q_norm_g": gain(ks[5], (L, A_HEAD_DIM)),
        "k_norm_g": gain(ks[6], (L, A_HEAD_DIM)),
        "lambda_q1": nrm(ks[7], (L, A_HEAD_DIM), 0.1),
        "lambda_k1": nrm(ks[8], (L, A_HEAD_DIM), 0.1),
        "lambda_q2": nrm(ks[9], (L, A_HEAD_DIM), 0.1),
        "lambda_k2": nrm(ks[10], (L, A_HEAD_DIM), 0.1),
        "subln_g": gain(ks[11], (L, A_V_DIM)),
        "w_out": nrm(ks[12], (L, D_MODEL, D_MODEL), D_MODEL ** -0.5),
        "norm2_g": gain(ks[13], (L, D_MODEL)),
        "w_query": nrm(ks[14], (L, D_MODEL, P_HEADS * P_KEY_DIM), D_MODEL ** -0.5),
        "sub_keys": nrm(ks[15], (L, P_HEADS, 2, N_KEYS, P_HALF), P_HALF ** -0.5),
        "expert_u": nrm(ks[16], (L, N_EXPERTS, D_MODEL), D_MODEL ** -0.5),
        "expert_v": nrm(ks[17], (L, N_EXPERTS, D_MODEL), P_HEADS ** -0.5),
    }


def reference(x, norm1_g, w_in, w_fourier, w_attn, q_norm_g, k_norm_g, lambda_q1, lambda_k1,
              lambda_q2, lambda_k2, subln_g, w_out, norm2_g, w_query, sub_keys, expert_u, expert_v):
    B, S, _ = x.shape
    slopes = alibi_slopes()
    o1 = F_WIDTH
    o2 = o1 + A_QK_WIDTH
    o3 = o2 + A_QK_WIDTH
    o4 = o3 + A_V_WIDTH
    o5 = o4 + D_MODEL
    h = x
    for i in range(DEPTH):
        lam_init = lambda_init_for(i)
        xn = rmsnorm(h, norm1_g[i])
        proj = xn @ w_in[i]
        z_f, q, k, v, gate_f, gate_a = jnp.split(proj, [o1, o2, o3, o4, o5], axis=-1)

        y_f = fourier_mix(z_f) @ w_fourier[i]

        q = rmsnorm(q.reshape(B, S, A_HEADS, 2, A_HEAD_DIM), q_norm_g[i])
        k = rmsnorm(k.reshape(B, S, A_HEADS, 2, A_HEAD_DIM), k_norm_g[i])
        v = v.reshape(B, S, A_HEADS, A_V_DIM)
        lam = (jnp.exp(jnp.sum(lambda_q1[i].astype(jnp.float32) * lambda_k1[i].astype(jnp.float32)))
               - jnp.exp(jnp.sum(lambda_q2[i].astype(jnp.float32) * lambda_k2[i].astype(jnp.float32)))
               + lam_init)
        o = diff_attention(q, k, v, lam, slopes)
        o = rmsnorm(o, subln_g[i]) * (1.0 - lam_init)
        y_a = o.reshape(B, S, A_V_WIDTH) @ w_attn[i]

        mixed = jax.nn.sigmoid(gate_f) * y_f + jax.nn.sigmoid(gate_a) * y_a
        h = h + mixed @ w_out[i]

        hn = rmsnorm(h, norm2_g[i])
        h = h + peer(hn, w_query[i], sub_keys[i], expert_u[i], expert_v[i])
    return h
```

```cpp
#include <hip/hip_runtime.h>
#include <hip/hip_cooperative_groups.h>
#include <cstdio>
#include <cstdint>
namespace cg = cooperative_groups;


#ifndef MK_ONE_LAUNCH
#define MK_ONE_LAUNCH 0
#endif

#define LAS __attribute__((address_space(3)))
typedef unsigned short bf16_t;
typedef short bf16x8 __attribute__((ext_vector_type(8)));
typedef short s16x4 __attribute__((ext_vector_type(4)));
typedef float f32x4 __attribute__((ext_vector_type(4)));
typedef float f32x16 __attribute__((ext_vector_type(16)));
typedef unsigned u32x4 __attribute__((ext_vector_type(4)));
typedef unsigned u32x2 __attribute__((ext_vector_type(2)));

constexpr int NTOK = 16384, DM = 2048, SEQ = 8192, NBATCH = 2, INW = 11264;
constexpr float EPS = 1e-6f;
constexpr float LAM_INIT = 0.2f;
constexpr float LOG2E = 1.4426950408889634f;
constexpr int NKC = 129;

constexpr size_t MiB = 1u << 20;
constexpr size_t WS_CTL = 0, CTL_BYTES = 4096;
constexpr size_t WS_TT = 1 * MiB + 64 * 1024, WS_F1 = 1 * MiB + 192 * 1024, WS_F2 = 1 * MiB + 320 * 1024;
constexpr size_t WS_SUBK = 2 * MiB;
constexpr size_t WS_WTIN = 4 * MiB, WS_A1 = WS_WTIN;
constexpr size_t WS_WTF = 48 * MiB, WS_WTA = 52 * MiB, WS_WTO = 60 * MiB, WS_WQ16 = 68 * MiB, WS_WTS = 76 * MiB;
constexpr size_t WS_XN = 84 * MiB, WS_A2 = WS_XN, WS_MIXED = WS_XN;
constexpr size_t WS_ZF = 148 * MiB, WS_YF = WS_ZF;
constexpr size_t WS_Q = 180 * MiB, WS_O = WS_Q, WS_HG = WS_Q;
constexpr size_t WS_K = 244 * MiB, WS_EU = WS_K;
constexpr size_t WS_V = 308 * MiB, WS_EV = WS_V;
constexpr size_t WS_GF = 372 * MiB, WS_SC = WS_GF;
constexpr size_t WS_GA = 436 * MiB;
constexpr size_t WS_END = 500 * MiB;
constexpr int CW_ATTQ = 64;

constexpr int RING_BYTES = 131072;
constexpr int EPI_OFF = RING_BYTES;
constexpr int LDS_BYTES = 153600;

__device__ __forceinline__ unsigned cvt_pk_bf16(float lo, float hi) { unsigned r; asm volatile("v_cvt_pk_bf16_f32 %0, %1, %2" : "=v"(r) : "v"(lo), "v"(hi)); return r; }
__device__ __forceinline__ float bf_lo(unsigned w) { return __uint_as_float(w << 16); }
__device__ __forceinline__ float bf_hi(unsigned w) { return __uint_as_float(w & 0xffff0000u); }
__device__ __forceinline__ float wave_sum(float v) {
#pragma unroll
    for (int o = 1; o < 64; o <<= 1) v += __shfl_xor(v, o);
    return v;
}
__device__ __forceinline__ float wave_max(float v) {
#pragma unroll
    for (int o = 1; o < 64; o <<= 1) v = fmaxf(v, __shfl_xor(v, o));
    return v;
}
#define LDS_WAIT() asm volatile("s_waitcnt lgkmcnt(0)" ::: "memory")
#define VM_WAIT() asm volatile("s_waitcnt vmcnt(0)" ::: "memory")

namespace g8 {
constexpr int BM = 256, BK = 64, HALF = 128, HTB = HALF * BK * 2;
__host__ __device__ __forceinline__ int lds_byte(int r, int c) { const int st = (r >> 4) * 2 + (c >> 5), rr = r & 15, cc = c & 31, ob = rr * 64 + cc * 2; return st * 1024 + (ob ^ (((ob >> 9) & 1) << 5)); }
__host__ __device__ __forceinline__ void stage_rc(int b, int& R, int& C) { const int st = b / 1024, sb = b % 1024, swz = sb ^ (((sb >> 9) & 1) << 5); R = (st >> 1) * 16 + swz / 64; C = (st & 1) * 32 + (swz % 64) / 2; }
__host__ __device__ __forceinline__ int perm32(int rho) { const int n = rho >> 4, i = rho & 15; return 8 * (i >> 2) + 4 * n + (i & 3); }

struct Unit { const char* a; const char* b; int pm, pn, aux; };
struct Geo { int K; unsigned rowA, halfA, rowB, halfB; };

template <class Epi, class Sched>
__device__ __forceinline__ void gemm_phase(LAS unsigned char* lds, const Geo g, const Sched& S, const Epi& E) {
    int tid_ = threadIdx.x; asm volatile("" : "+v"(tid_));
    const int tid = tid_, wid = __builtin_amdgcn_readfirstlane(tid >> 6), lane = tid & 63, wr = wid >> 2, wc = wid & 3, fr = lane & 15, fq = lane >> 4;
    const int nt = g.K / BK;
    unsigned voffA[2], voffB[2];
#pragma unroll
    for (int i = 0; i < 2; ++i) { int R, C; stage_rc(tid * 16 + i * 8192, R, C); const int Rb = Epi::PERM ? ((R & ~31) + perm32(R & 31)) : R;
        voffA[i] = (unsigned)R * g.rowA + (unsigned)C * 2u; voffB[i] = (unsigned)Rb * g.rowB + (unsigned)C * 2u; }
    const size_t kstep = (size_t)(BK * 2);
    const size_t hA = g.halfA, hB = g.halfB;
    const unsigned ldsw = (unsigned)wid * 1024u;
    const int aoff = lds_byte(wr * 64 + fr, fq * 8), boff = lds_byte(wc * 32 + fr, fq * 8);
#define G8_SA(b, h) (((b) * 2 + (h)) * HTB)
#define G8_SB(b, h) ((4 + (b) * 2 + (h)) * HTB)
#define G8_STAGE(bufoff, gbase, voff) do { _Pragma("unroll") for (int _i = 0; _i < 2; ++_i) \
        __builtin_amdgcn_global_load_lds((const unsigned*)((const char*)(gbase) + (voff)[_i]), (LAS unsigned*)(lds + (bufoff) + ldsw + _i * 8192), 16, 0, 0); } while (0)
#define G8_LDA(dst, b, h) do { _Pragma("unroll") for (int m = 0; m < 4; ++m) _Pragma("unroll") for (int k = 0; k < 2; ++k) dst[m][k] = *(const LAS bf16x8*)(lds + G8_SA(b, h) + aoff + m * 2048 + k * 1024); } while (0)
#define G8_LDB(dst, b, h) do { _Pragma("unroll") for (int n = 0; n < 2; ++n) _Pragma("unroll") for (int k = 0; k < 2; ++k) dst[n][k] = *(const LAS bf16x8*)(lds + G8_SB(b, h) + boff + n * 2048 + k * 1024); } while (0)
#define G8_MMA(ai, bj, At, Bt) do { __builtin_amdgcn_s_setprio(1); _Pragma("unroll") for (int m = 0; m < 4; ++m) _Pragma("unroll") for (int n = 0; n < 2; ++n) _Pragma("unroll") for (int k = 0; k < 2; ++k) \
        acc[ai][bj][m][n] = Epi::SWAP ? __builtin_amdgcn_mfma_f32_16x16x32_bf16(Bt[n][k], At[m][k], acc[ai][bj][m][n], 0, 0, 0) \
                                      : __builtin_amdgcn_mfma_f32_16x16x32_bf16(At[m][k], Bt[n][k], acc[ai][bj][m][n], 0, 0, 0); __builtin_amdgcn_s_setprio(0); } while (0)
#define G8_WAIT_V(n) asm volatile("s_waitcnt vmcnt(" #n ")" ::: "memory")
#define G8_WAIT_L(n) asm volatile("s_waitcnt lgkmcnt(" #n ")" ::: "memory")
#define G8_BAR __builtin_amdgcn_s_barrier()
#define G8_SCHED __builtin_amdgcn_sched_barrier(0)
    Unit cur, nxt; int ui = 0;
    if (!S.next(0, cur)) return;
    f32x4 acc[2][2][4][2];
#pragma unroll
    for (int a = 0; a < 2; ++a)
#pragma unroll
        for (int b = 0; b < 2; ++b)
#pragma unroll
            for (int m = 0; m < 4; ++m)
#pragma unroll
                for (int n = 0; n < 2; ++n) acc[a][b][m][n] = (f32x4){0.f, 0.f, 0.f, 0.f};
    bf16x8 At[4][2], B0[2][2], B1[2][2];
    const char* cA = cur.a; const char* cB = cur.b;
    G8_STAGE(G8_SB(0, 0), cB, voffB); G8_STAGE(G8_SB(0, 1), cB + hB, voffB); G8_STAGE(G8_SA(0, 0), cA, voffA); G8_STAGE(G8_SA(0, 1), cA + hA, voffA);
    if (wr == 1) G8_BAR;
    G8_WAIT_V(2); G8_BAR;
    G8_STAGE(G8_SB(1, 0), cB + kstep, voffB); G8_STAGE(G8_SA(1, 0), cA + kstep, voffA); G8_STAGE(G8_SB(1, 1), cB + hB + kstep, voffB);
    G8_WAIT_V(6); G8_BAR;
    for (;;) {
        const bool has_next = S.next(ui + 1, nxt);
        const char* nA = has_next ? nxt.a : cA; const char* nB = has_next ? nxt.b : cB;
        for (int t = 0; t < nt; t += 2) {
            const bool last = (t == nt - 2);
            const char* a1 = cA + (size_t)(t + 1) * kstep;
            const char* a2 = last ? nA : cA + (size_t)(t + 2) * kstep; const char* b2 = last ? nB : cB + (size_t)(t + 2) * kstep;
            const char* a3 = a2 + kstep; const char* b3 = b2 + kstep;
            G8_LDB(B0, 0, 0); G8_LDB(B1, 0, 1); G8_SCHED; G8_LDA(At, 0, 0); G8_STAGE(G8_SA(1, 1), a1 + hA, voffA);
            G8_WAIT_V(8); G8_WAIT_L(0); G8_BAR; G8_MMA(0, 0, At, B0); G8_MMA(0, 1, At, B1); G8_BAR; G8_SCHED;
            G8_LDA(At, 0, 1); G8_STAGE(G8_SB(0, 0), b2, voffB); G8_STAGE(G8_SB(0, 1), b2 + hB, voffB); G8_STAGE(G8_SA(0, 0), a2, voffA);
            G8_WAIT_V(8); G8_WAIT_L(0); G8_BAR; G8_MMA(1, 0, At, B0); G8_MMA(1, 1, At, B1); G8_BAR; G8_SCHED;
            G8_LDB(B0, 1, 0); G8_LDB(B1, 1, 1); G8_SCHED; G8_LDA(At, 1, 0); G8_STAGE(G8_SA(0, 1), a2 + hA, voffA);
            G8_WAIT_V(8); G8_WAIT_L(0); G8_BAR; G8_MMA(0, 0, At, B0); G8_MMA(0, 1, At, B1); G8_BAR; G8_SCHED;
            G8_LDA(At, 1, 1); G8_STAGE(G8_SB(1, 0), b3, voffB); G8_STAGE(G8_SB(1, 1), b3 + hB, voffB); G8_STAGE(G8_SA(1, 0), a3, voffA);
            G8_WAIT_V(8); G8_WAIT_L(0); G8_BAR; G8_MMA(1, 0, At, B0); G8_MMA(1, 1, At, B1); G8_BAR; G8_SCHED;
        }
        if (wr == 0) G8_BAR;
        E(acc, cur, wr, wc, fr, fq, lds + EPI_OFF);
        if (!has_next) break;
#pragma unroll
        for (int a = 0; a < 2; ++a)
#pragma unroll
            for (int b = 0; b < 2; ++b)
#pragma unroll
                for (int m = 0; m < 4; ++m)
#pragma unroll
                    for (int n = 0; n < 2; ++n) acc[a][b][m][n] = (f32x4){0.f, 0.f, 0.f, 0.f};
        cur = nxt; cA = nA; cB = nB; ++ui;
        if (wr == 1) G8_BAR;
    }
    G8_WAIT_V(0);
    G8_BAR;
#undef G8_SA
#undef G8_SB
#undef G8_STAGE
#undef G8_LDA
#undef G8_LDB
#undef G8_MMA
}
}

enum { K_INPROJ = 0, K_FOLD, K_YA, K_YF, K_OUT, K_SC, K_STEPA, K_STAGE1, K_STAGE2 };

struct Ptrs { float* out; unsigned char* ws; };
__device__ __forceinline__ const float* inptr(int i) {
    const __attribute__((address_space(4))) char* kp = (const __attribute__((address_space(4))) char*)__builtin_amdgcn_kernarg_segment_ptr();
    return *(const float* const __attribute__((address_space(4)))*)(kp + i * 8);
}

__device__ __forceinline__ void tile_order(int L, int nM, int nN, int& pm, int& pn) {
    const int nwg = nM * nN; constexpr int NXCD = 8, WGM = 8;
    int wgid = L; { const int q = nwg / NXCD, r = nwg % NXCD, xcd = wgid % NXCD, off = wgid / NXCD; wgid = (xcd < r ? xcd * (q + 1) : r * (q + 1) + (xcd - r) * q) + off; }
    const int nig = WGM * nN, gid = wgid / nig, fm = gid * WGM, gsz = (nM - fm) < WGM ? (nM - fm) : WGM;
    pm = fm + ((wgid % nig) % gsz); pn = (wgid % nig) / gsz;
}

template <int kind> struct Sched {
    int G, c; unsigned char* ws;
    __device__ __forceinline__ bool next(int i, g8::Unit& u) const {
        const int L = i * G + c;
        switch (kind) {
        case K_INPROJ: { if (L >= 64 * 44) return false; tile_order(L, 64, 44, u.pm, u.pn);
            u.a = (const char*)(ws + WS_XN) + (size_t)u.pm * 256 * DM * 2; u.b = (const char*)(ws + WS_WTIN) + (size_t)u.pn * 256 * DM * 2; u.aux = 0; return true; }
        case K_FOLD: { if (L >= 64) return false; u.pm = L >> 3; u.pn = L & 7;
            u.a = (const char*)(ws + WS_SUBK) + (size_t)u.pm * 256 * 256 * 2; u.b = (const char*)(ws + WS_WQ16) + ((size_t)u.pn * 256 * DM + (size_t)u.pm * 256) * 2; u.aux = 0; return true; }
        case K_YA: { if (L >= 512) return false; tile_order(L, 64, 8, u.pm, u.pn);
            u.a = (const char*)(ws + WS_O) + (size_t)u.pm * 256 * DM * 2; u.b = (const char*)(ws + WS_WTA) + (size_t)u.pn * 256 * DM * 2; u.aux = 0; return true; }
        case K_YF: { if (L >= 512) return false; tile_order(L, 64, 8, u.pm, u.pn);
            u.a = (const char*)(ws + WS_YF) + (size_t)u.pm * 256 * 1024 * 2; u.b = (const char*)(ws + WS_WTF) + (size_t)u.pn * 256 * 1024 * 2; u.aux = 0; return true; }
        case K_OUT: { if (L >= 512) return false; tile_order(L, 64, 8, u.pm, u.pn);
            u.a = (const char*)(ws + WS_MIXED) + (size_t)u.pm * 256 * DM * 2; u.b = (const char*)(ws + WS_WTO) + (size_t)u.pn * 256 * DM * 2; u.aux = 0; return true; }
        case K_SC: { if (L >= 512) return false; tile_order(L, 64, 8, u.pm, u.pn);
            u.a = (const char*)(ws + WS_HG) + (size_t)u.pm * 256 * DM * 2; u.b = (const char*)(ws + WS_WTS) + (size_t)u.pn * 256 * DM * 2; u.aux = 0; return true; }
        case K_STEPA: { if (L >= 256) return false; const int bg = L >> 5, q = L & 31, b = bg >> 2, gr = bg & 3; u.pm = bg; u.pn = 0; u.aux = q;
            u.a = (const char*)(ws + WS_ZF) + ((size_t)(b * SEQ + 2 * q) * 1024 + gr * 256) * 2; u.b = (const char*)(ws + WS_TT); return true; }
        case K_STAGE1: { if (L >= 258) return false; u.pm = L; u.pn = 0; u.aux = 0;
            u.a = (const char*)(ws + WS_A1) + (size_t)L * 256 * 512; u.b = (const char*)(ws + WS_F1); return true; }
        case K_STAGE2: { if (L >= 516) return false; u.pm = L; u.pn = 0; u.aux = 0;
            u.a = (const char*)(ws + WS_A2) + (size_t)L * 256 * 256; u.b = (const char*)(ws + WS_F2); return true; }
        }
        return false;
    }
};
__host__ __device__ constexpr g8::Geo geo_of(int kind) {
    switch (kind) {
    case K_INPROJ: case K_YA: case K_OUT: case K_SC: return g8::Geo{2048, 4096u, 128u * 4096u, 4096u, 128u * 4096u};
    case K_FOLD: return g8::Geo{256, 512u, 128u * 512u, 4096u, 128u * 4096u};
    case K_YF: return g8::Geo{1024, 2048u, 128u * 2048u, 2048u, 128u * 2048u};
    case K_STEPA: return g8::Geo{256, 64u * 2048u, 2048u, 512u, 128u * 512u};
    case K_STAGE1: return g8::Geo{256, 512u, 128u * 512u, 512u, 128u * 512u};
    default: return g8::Geo{128, 256u, 128u * 256u, 256u, 128u * 256u};
    }
}

__device__ __forceinline__ void st8_bf16(bf16_t* p, f32x4 v0, f32x4 v1) {
    u32x4 w; w.x = cvt_pk_bf16(v0[0], v0[1]); w.y = cvt_pk_bf16(v0[2], v0[3]); w.z = cvt_pk_bf16(v1[0], v1[1]); w.w = cvt_pk_bf16(v1[2], v1[3]);
    *(u32x4*)p = w;
}
__device__ __forceinline__ void ld8_bf16(const bf16_t* p, f32x4& v0, f32x4& v1) {
    const u32x4 w = *(const u32x4*)p;
    v0 = (f32x4){bf_lo(w.x), bf_hi(w.x), bf_lo(w.y), bf_hi(w.y)}; v1 = (f32x4){bf_lo(w.z), bf_hi(w.z), bf_lo(w.w), bf_hi(w.w)};
}
__device__ __forceinline__ float sigmoidf_(float x) { return 1.0f / (1.0f + __expf(-x)); }

template <int kind> struct EpiRM {
    static constexpr bool PERM = true, SWAP = true;
    Ptrs P;
    __device__ __forceinline__ void operator()(f32x4 (&acc)[2][2][4][2], const g8::Unit& u, int wr, int wc, int fr_, int fq_, LAS unsigned char* elds) const {
        unsigned char* ws = P.ws;
        int fr = fr_, fq = fq_; asm volatile("" : "+v"(fr), "+v"(fq));
        const int row0 = u.pm * 256 + wr * 64 + fr;
        const int ct = wc * 32 + 8 * fq;
        if (kind == K_INPROJ) {
            const int pn = u.pn;
            if (pn < 4) {
                bf16_t* O = (bf16_t*)(ws + WS_ZF);
#pragma unroll
                for (int ai = 0; ai < 2; ++ai)
#pragma unroll
                    for (int m = 0; m < 4; ++m)
#pragma unroll
                        for (int bj = 0; bj < 2; ++bj) st8_bf16(O + (size_t)(row0 + ai * 128 + m * 16) * 1024 + pn * 256 + ct + bj * 128, acc[ai][bj][m][0], acc[ai][bj][m][1]);
            } else if (pn < 20) {
                const bool isq = pn < 12;
                LAS float* Pl = (LAS float*)elds;
#pragma unroll
                for (int ai = 0; ai < 2; ++ai)
#pragma unroll
                    for (int m = 0; m < 4; ++m)
#pragma unroll
                        for (int bj = 0; bj < 2; ++bj) {
                            const f32x4 a = acc[ai][bj][m][0], b = acc[ai][bj][m][1];
                            float s = (a[0] * a[0] + a[1] * a[1]) + (a[2] * a[2] + a[3] * a[3]) + (b[0] * b[0] + b[1] * b[1]) + (b[2] * b[2] + b[3] * b[3]);
                            s += __shfl_xor(s, 16); s += __shfl_xor(s, 32);
                            if (fq == 0) Pl[((ai * 128 + wr * 64 + m * 16 + fr) * 2 + bj) * 4 + wc] = s;
                        }
                LDS_WAIT(); __builtin_amdgcn_s_barrier(); asm volatile("" ::: "memory");
                const float* gsrc = isq ? inptr(5) : inptr(6);
                const float extra = isq ? (0.08838834764831845f * LOG2E) : 1.0f;
                const f32x4 g0 = *(const f32x4*)(gsrc + ct) * extra, g1 = *(const f32x4*)(gsrc + ct + 4) * extra;
                bf16_t* O = (bf16_t*)(ws + (isq ? WS_Q : WS_K));
                const int cbase = (isq ? (pn - 4) : (pn - 12)) * 256;
#pragma unroll
                for (int ai = 0; ai < 2; ++ai)
#pragma unroll
                    for (int m = 0; m < 4; ++m)
#pragma unroll
                        for (int bj = 0; bj < 2; ++bj) {
                            const f32x4 t = *(const LAS f32x4*)(Pl + ((ai * 128 + wr * 64 + m * 16 + fr) * 2 + bj) * 4);
                            const float rinv = 1.0f / sqrtf(((t[0] + t[1]) + (t[2] + t[3])) * (1.0f / 128.0f) + EPS);
                            st8_bf16(O + (size_t)(row0 + ai * 128 + m * 16) * DM + cbase + ct + bj * 128, acc[ai][bj][m][0] * rinv * g0, acc[ai][bj][m][1] * rinv * g1);
                        }
                LDS_WAIT(); __builtin_amdgcn_s_barrier(); asm volatile("" ::: "memory");
            } else if (pn < 28) {
                bf16_t* O = (bf16_t*)(ws + WS_V); const int cbase = (pn - 20) * 256;
#pragma unroll
                for (int ai = 0; ai < 2; ++ai)
#pragma unroll
                    for (int m = 0; m < 4; ++m)
#pragma unroll
                        for (int bj = 0; bj < 2; ++bj) st8_bf16(O + (size_t)(row0 + ai * 128 + m * 16) * DM + cbase + ct + bj * 128, acc[ai][bj][m][0], acc[ai][bj][m][1]);
            } else {
                bf16_t* O = (bf16_t*)(ws + (pn < 36 ? WS_GF : WS_GA)); const int cbase = (pn < 36 ? pn - 28 : pn - 36) * 256;
#pragma unroll
                for (int ai = 0; ai < 2; ++ai)
#pragma unroll
                    for (int m = 0; m < 4; ++m)
#pragma unroll
                        for (int bj = 0; bj < 2; ++bj) {
                            f32x4 a = acc[ai][bj][m][0], b = acc[ai][bj][m][1];
#pragma unroll
                            for (int x = 0; x < 4; ++x) { a[x] = sigmoidf_(a[x]); b[x] = sigmoidf_(b[x]); }
                            st8_bf16(O + (size_t)(row0 + ai * 128 + m * 16) * DM + cbase + ct + bj * 128, a, b);
                        }
            }
        } else if (kind == K_FOLD) {
            bf16_t* O = (bf16_t*)(ws + WS_WTS);
#pragma unroll
            for (int ai = 0; ai < 2; ++ai)
#pragma unroll
                for (int m = 0; m < 4; ++m)
#pragma unroll
                    for (int bj = 0; bj < 2; ++bj) st8_bf16(O + (size_t)(row0 + ai * 128 + m * 16) * DM + u.pn * 256 + ct + bj * 128, acc[ai][bj][m][0], acc[ai][bj][m][1]);
        } else if (kind == K_YA || kind == K_YF) {
            bf16_t* O = (bf16_t*)(ws + WS_MIXED); const bf16_t* Gt = (const bf16_t*)(ws + (kind == K_YA ? WS_GA : WS_GF));
#pragma unroll
            for (int ai = 0; ai < 2; ++ai)
#pragma unroll
                for (int m = 0; m < 4; ++m)
#pragma unroll
                    for (int bj = 0; bj < 2; ++bj) {
                        const size_t off = (size_t)(row0 + ai * 128 + m * 16) * DM + u.pn * 256 + ct + bj * 128;
                        f32x4 g0, g1; ld8_bf16(Gt + off, g0, g1);
                        f32x4 a = acc[ai][bj][m][0] * g0, b = acc[ai][bj][m][1] * g1;
                        if (kind == K_YF) { f32x4 p0, p1; ld8_bf16(O + off, p0, p1); a += p0; b += p1; }
                        st8_bf16(O + off, a, b);
                    }
        } else if (kind == K_OUT) {
            const float* X = inptr(0); float* H = P.out; bf16_t* HG = (bf16_t*)(ws + WS_HG); const float* g2 = inptr(13);
#pragma unroll
            for (int bj = 0; bj < 2; ++bj) {
                const int col = u.pn * 256 + ct + bj * 128;
                const f32x4 ga = *(const f32x4*)(g2 + col), gb = *(const f32x4*)(g2 + col + 4);
#pragma unroll
                for (int ai = 0; ai < 2; ++ai)
#pragma unroll
                    for (int m = 0; m < 4; ++m) {
                        const size_t off = (size_t)(row0 + ai * 128 + m * 16) * DM + col;
                        const f32x4 h0 = *(const f32x4*)(X + off) + acc[ai][bj][m][0], h1 = *(const f32x4*)(X + off + 4) + acc[ai][bj][m][1];
                        *(f32x4*)(H + off) = h0; *(f32x4*)(H + off + 4) = h1;
                        st8_bf16(HG + off, h0 * ga, h1 * gb);
                    }
            }
        } else {
            float* SC = (float*)(ws + WS_SC);
#pragma unroll
            for (int ai = 0; ai < 2; ++ai)
#pragma unroll
                for (int m = 0; m < 4; ++m)
#pragma unroll
                    for (int bj = 0; bj < 2; ++bj) {
                        const size_t off = (size_t)(row0 + ai * 128 + m * 16) * DM + u.pn * 256 + ct + bj * 128;
                        *(f32x4*)(SC + off) = acc[ai][bj][m][0]; *(f32x4*)(SC + off + 4) = acc[ai][bj][m][1];
                    }
        }
    }
};

template <int kind> struct EpiT {
    static constexpr bool PERM = false, SWAP = false;
    Ptrs P;
    __device__ __forceinline__ void operator()(f32x4 (&acc)[2][2][4][2], const g8::Unit& u, int wr, int wc, int fr_, int fq_, LAS unsigned char* elds) const {
        unsigned char* ws = P.ws;
        int fr = fr_, fq = fq_; asm volatile("" : "+v"(fr), "+v"(fq));
        if (kind == K_STEPA) {
            bf16_t* A1 = (bf16_t*)(ws + WS_A1); const int bg = u.pm, q = u.aux;
#pragma unroll
            for (int ai = 0; ai < 2; ++ai)
#pragma unroll
                for (int bj = 0; bj < 2; ++bj)
#pragma unroll
                    for (int m = 0; m < 4; ++m)
#pragma unroll
                        for (int n = 0; n < 2; ++n) {
                            const int n1 = wr * 64 + m * 16 + 4 * fq, n2 = 2 * q + ai, jp = bj * 128 + wc * 32 + n * 16 + fr;
                            const int kc = jp <= 128 ? jp : jp - 128, ri = jp <= 128 ? 0 : 1;
                            const f32x4 v = acc[ai][bj][m][n];
                            u32x2 w; w.x = cvt_pk_bf16(v[0], v[1]); w.y = cvt_pk_bf16(v[2], v[3]);
                            *(u32x2*)(A1 + ((size_t)((bg * NKC + kc) * 64 + n2) * 2 + ri) * 128 + n1) = w;
                            if (jp == 0 || jp == 128) *(u32x2*)(A1 + ((size_t)((bg * NKC + kc) * 64 + n2) * 2 + 1) * 128 + n1) = (u32x2){0u, 0u};
                            __builtin_amdgcn_sched_barrier(0);
                        }
        } else if (kind == K_STAGE1) {
            bf16_t* A2 = (bf16_t*)(ws + WS_A2);
#pragma unroll
            for (int ai = 0; ai < 2; ++ai)
#pragma unroll
                for (int m = 0; m < 4; ++m) {
                    const int Rg = u.pm * 256 + ai * 128 + wr * 64 + m * 16 + 4 * fq, bgkc = Rg >> 6, n2 = Rg & 63, bg = bgkc / NKC, kc = bgkc - bg * NKC;
#pragma unroll
                    for (int n = 0; n < 2; ++n) {
                        const int k1 = wc * 32 + n * 16 + fr;
                        const f32x4 re = acc[ai][0][m][n], im = acc[ai][1][m][n]; f32x4 orr, oi;
#pragma unroll
                        for (int x = 0; x < 4; ++x) {
                            const float ph = (float)(((n2 + x) * k1) & 8191) * (1.0f / 8192.0f);
                            const float c = __builtin_amdgcn_cosf(ph), s = __builtin_amdgcn_sinf(ph);
                            orr[x] = re[x] * c + im[x] * s; oi[x] = im[x] * c - re[x] * s;
                        }
                        bf16_t* dst = A2 + ((size_t)((bg * 128 + k1) * NKC + kc) * 2) * 64 + n2;
                        u32x2 w0, w1; w0.x = cvt_pk_bf16(orr[0], orr[1]); w0.y = cvt_pk_bf16(orr[2], orr[3]); w1.x = cvt_pk_bf16(oi[0], oi[1]); w1.y = cvt_pk_bf16(oi[2], oi[3]);
                        *(u32x2*)dst = w0; *(u32x2*)(dst + 64) = w1;
                        __builtin_amdgcn_sched_barrier(0);
                    }
                }
        } else {
            if (wc < 2) {
                bf16_t* YF = (bf16_t*)(ws + WS_YF);
#pragma unroll
                for (int ai = 0; ai < 2; ++ai)
#pragma unroll
                    for (int m = 0; m < 4; ++m)
#pragma unroll
                        for (int n = 0; n < 2; ++n) {
                            const int k2 = wc * 32 + n * 16 + fr; const f32x4 v = acc[ai][0][m][n];
#pragma unroll
                            for (int x = 0; x < 4; ++x) {
                                const int Rg = u.pm * 256 + ai * 128 + wr * 64 + m * 16 + 4 * fq + x, bg = Rg / (128 * NKC), rem = Rg - bg * (128 * NKC), k1 = rem / NKC, kc = rem - k1 * NKC;
                                const int b = bg >> 2, gr = bg & 3, k = k1 + 128 * k2;
                                const bf16_t o = (bf16_t)(cvt_pk_bf16(v[x], 0.f) & 0xffffu);
                                if (kc <= 128) YF[(size_t)(b * SEQ + k) * 1024 + gr * 256 + kc] = o;
                                if (kc >= 1 && kc <= 127) YF[(size_t)(b * SEQ + ((SEQ - k) & (SEQ - 1))) * 1024 + gr * 256 + 256 - kc] = o;
                            }
                        }
            }
        }
    }
};

namespace att {
constexpr int KSLOT = 16384, VSLOT = 16384, NSLOT = 3;
constexpr int L_K = 0, L_V = NSLOT * KSLOT, L_WS = 131072;
__device__ __forceinline__ int crow(int r, int hi) { return (r & 3) + 8 * (r >> 2) + 4 * hi; }
#define SBAR() __builtin_amdgcn_sched_barrier(0)
template <int OFF> __device__ __forceinline__ s16x4 tr_read(int vb) {
    s16x4 r; asm volatile("ds_read_b64_tr_b16 %0, %1 offset:%2" : "=&v"(r) : "v"(vb), "i"(OFF) : "memory"); return r;
}
template <int D0, int KH> __device__ __forceinline__ void pv_half(f32x16& od, int vb, bf16x8 pa, bf16x8 pb) {
    const s16x4 l0 = tr_read<D0 * 512 + (2 * KH) * 4096>(vb), h0 = tr_read<D0 * 512 + (2 * KH) * 4096 + 2048>(vb);
    const s16x4 l1 = tr_read<D0 * 512 + (2 * KH + 1) * 4096>(vb), h1 = tr_read<D0 * 512 + (2 * KH + 1) * 4096 + 2048>(vb);
    asm volatile("s_waitcnt lgkmcnt(0)" ::: "memory"); SBAR();
#define PKV(L, H) (bf16x8){L[0], L[1], L[2], L[3], H[0], H[1], H[2], H[3]}
    od = __builtin_amdgcn_mfma_f32_32x32x16_bf16(pa, PKV(l0, h0), od, 0, 0, 0);
    od = __builtin_amdgcn_mfma_f32_32x32x16_bf16(pb, PKV(l1, h1), od, 0, 0, 0);
#undef PKV
}
#define KSWZ(row, colB) ((row) * 256 + ((colB) ^ (((row) & 7) << 4)))
#define PK4(Pv, BASE, OUT) do { unsigned a0 = cvt_pk_bf16(Pv[BASE + 0], Pv[BASE + 1]), a1 = cvt_pk_bf16(Pv[BASE + 2], Pv[BASE + 3]);   \
    unsigned b0_ = cvt_pk_bf16(Pv[BASE + 4], Pv[BASE + 5]), b1_ = cvt_pk_bf16(Pv[BASE + 6], Pv[BASE + 7]);                              \
    auto r0 = __builtin_amdgcn_permlane32_swap(a0, b0_, false, false); auto r1 = __builtin_amdgcn_permlane32_swap(a1, b1_, false, false); \
    u32x4 w = {r0[0], r1[0], r0[1], r1[1]}; OUT = __builtin_bit_cast(bf16x8, w); } while (0)

template <int KH> __device__ __forceinline__ void half_tile(f32x16 (&o)[4], float& lsum, const bf16x8 (&qr)[8], const LAS unsigned char* Ks, int vb, float dq, float nslope2, float negM2, int r32, int hi) {
    f32x16 p;
#pragma unroll
    for (int r = 0; r < 16; ++r) { const float cr = (float)((r & 3) + 8 * (r >> 2) + 32 * KH); p[r] = __builtin_fmaf(nslope2, __builtin_fabsf(dq - cr), negM2); }
#pragma unroll
    for (int d0 = 0; d0 < 8; ++d0) { const int cb = (d0 * 16 + hi * 8) * 2;
        const bf16x8 bk = *(const LAS bf16x8*)(Ks + KSWZ(32 * KH + r32, cb));
        p = __builtin_amdgcn_mfma_f32_32x32x16_bf16(bk, qr[d0], p, 0, 0, 0); }
    float ps = 0.f;
#pragma unroll
    for (int r = 0; r < 16; ++r) { p[r] = __builtin_amdgcn_exp2f(p[r]); ps += p[r]; }
    lsum += ps;
    bf16x8 pa, pb;
    PK4(p, 0, pa); PK4(p, 8, pb);
    pv_half<0, KH>(o[0], vb, pa, pb); pv_half<1, KH>(o[1], vb, pa, pb); pv_half<2, KH>(o[2], vb, pa, pb); pv_half<3, KH>(o[3], vb, pa, pb);
}

__device__ __forceinline__ void attn_pass(f32x16 (&o)[4], int b, int h, int c, int e, int qb, int t_lo, int NT, float nslope2, float negM2,
                                          const bf16_t* __restrict__ Q, const bf16_t* __restrict__ K, const bf16_t* __restrict__ V, LAS unsigned char* lds) {
    int tid_ = threadIdx.x; asm volatile("" : "+v"(tid_));
    const int tid = tid_, lane = tid & 63, r32 = lane & 31, hi = lane >> 5; const int wid = __builtin_amdgcn_readfirstlane(tid >> 6);
    const size_t rowbase = (size_t)b * SEQ;
    bf16x8 qr[8];
    { const bf16_t* Qw = Q + (rowbase + qb * 256 + wid * 32 + r32) * DM + h * 256 + c * 128 + hi * 8;
#pragma unroll
      for (int d0 = 0; d0 < 8; ++d0) qr[d0] = *(const bf16x8*)(Qw + d0 * 16); }
    const bf16_t* Kh = K + rowbase * DM + h * 256 + c * 128; const bf16_t* Vh = V + rowbase * DM + h * 256 + e * 128;
#define DMA_TILE(t, slot) do { const bf16_t* kb_ = Kh + (size_t)(t) * 64 * DM; const bf16_t* vb_ = Vh + (size_t)(t) * 64 * DM; \
        _Pragma("unroll") for (int _i = 0; _i < 2; ++_i) { const int p_ = 2 * wid + _i, row_ = 4 * p_ + (lane >> 4), c16_ = lane & 15; \
            __builtin_amdgcn_global_load_lds((const unsigned*)(kb_ + (unsigned)row_ * DM + (unsigned)((c16_ ^ (row_ & 7)) * 8)), (LAS unsigned*)(lds + L_K + (slot) * KSLOT + p_ * 1024), 16, 0, 0); } \
        _Pragma("unroll") for (int _i = 0; _i < 2; ++_i) { const int p_ = 2 * wid + _i, kg_ = p_ >> 1, cb_ = 2 * (p_ & 1) + (lane >> 5), kk_ = kg_ * 8 + ((lane >> 2) & 7); \
            const int key_ = (kk_ & ~0xC) | ((kk_ & 4) << 1) | ((kk_ & 8) >> 1); \
            __builtin_amdgcn_global_load_lds((const unsigned*)(vb_ + (unsigned)key_ * DM + (unsigned)(cb_ * 32 + (lane & 3) * 8)), (LAS unsigned*)(lds + L_V + (slot) * VSLOT + p_ * 1024), 16, 0, 0); } } while (0)
    const int vrd = ((lane & 3) << 3) | (((lane >> 2) & 3) << 6) | (((lane >> 4) & 1) << 5) | (((lane >> 5) & 1) << 8);
    const int vb0 = (int)(unsigned)(uintptr_t)(lds + L_V) + vrd;
#pragma unroll
    for (int d = 0; d < 4; ++d) o[d] = f32x16{};
    float lsum = 0.f;
    const int qpos = qb * 256 + wid * 32 + r32;
    DMA_TILE(t_lo, 0);
    if (NT > 1) DMA_TILE(t_lo + 1, 1);
    int slot = 0, slot2 = 2;
    for (int j = 0; j < NT; ++j) {
        if (j + 1 < NT) asm volatile("s_waitcnt vmcnt(4)" ::: "memory"); else asm volatile("s_waitcnt vmcnt(0)" ::: "memory");
        __builtin_amdgcn_s_barrier(); asm volatile("" ::: "memory");
        if (j + 2 < NT) DMA_TILE(t_lo + j + 2, slot2);
        const LAS unsigned char* Ks = lds + L_K + slot * KSLOT; const int vb = vb0 + slot * VSLOT;
        const float dq = (float)(qpos - (t_lo + j) * 64 - 4 * hi);
        half_tile<0>(o, lsum, qr, Ks, vb, dq, nslope2, negM2, r32, hi);
        half_tile<1>(o, lsum, qr, Ks, vb, dq, nslope2, negM2, r32, hi);
        slot = (slot == NSLOT - 1) ? 0 : slot + 1;
        slot2 = (slot2 == NSLOT - 1) ? 0 : slot2 + 1;
    }
    LDS_WAIT(); __builtin_amdgcn_s_barrier(); asm volatile("" ::: "memory");
    { auto rr = __builtin_amdgcn_permlane32_swap(__float_as_uint(lsum), __float_as_uint(lsum), false, false); lsum = __uint_as_float(rr[0]) + __uint_as_float(rr[1]); }
    LAS float* wsf = (LAS float*)(lds + L_WS) + wid * 64;
    if (hi == 0) wsf[r32] = lsum; LDS_WAIT();
#pragma unroll
    for (int r = 0; r < 16; ++r) { const float rl = __builtin_amdgcn_rcpf(wsf[crow(r, hi)]);
#pragma unroll
        for (int d = 0; d < 4; ++d) o[d][r] *= rl; }
    LDS_WAIT();
#undef DMA_TILE
}

__device__ __forceinline__ void attn_unit(int unit, const Ptrs& P, LAS unsigned char* lds, float lam, float Mb) {
    int tid_ = threadIdx.x; asm volatile("" : "+v"(tid_));
    const int tid = tid_, lane = tid & 63, r32 = lane & 31, hi = lane >> 5; const int wid = __builtin_amdgcn_readfirstlane(tid >> 6);
    const int hidx = 7 - (unit >> 6), rem = unit & 63, b = rem >> 5, qb = rem & 31;
    const float slope = exp2f(-(float)(hidx + 1));
    int w = (int)ceilf((2.f * Mb + 104.f) / slope); if (w > SEQ) w = SEQ;
    const int klo = (qb * 256 - w) < 0 ? 0 : (qb * 256 - w), khi = (qb * 256 + 255 + w) > (SEQ - 1) ? (SEQ - 1) : (qb * 256 + 255 + w);
    const int t_lo = klo >> 6, NT = (khi >> 6) - t_lo + 1;
    const bf16_t* Q = (const bf16_t*)(P.ws + WS_Q); const bf16_t* K = (const bf16_t*)(P.ws + WS_K); const bf16_t* V = (const bf16_t*)(P.ws + WS_V);
    float* stash = P.out + ((size_t)blockIdx.x * 512 + tid) * 192;
    float ss[16];
#pragma unroll
    for (int r = 0; r < 16; ++r) ss[r] = 0.f;
    for (int e = 0; e < 2; ++e) {
        f32x16 o[4];
#ifndef DBG_NO_PASS
        attn_pass(o, b, hidx, 0, e, qb, t_lo, NT, -slope * LOG2E, -Mb * LOG2E, Q, K, V, lds);
#else
        for (int d = 0; d < 4; ++d) o[d] = f32x16{};
#endif
#pragma unroll
        for (int d = 0; d < 4; ++d)
#pragma unroll
            for (int r4 = 0; r4 < 4; ++r4) *(f32x4*)(stash + d * 16 + r4 * 4) = (f32x4){o[d][r4 * 4], o[d][r4 * 4 + 1], o[d][r4 * 4 + 2], o[d][r4 * 4 + 3]};
#ifndef DBG_NO_PASS
        attn_pass(o, b, hidx, 1, e, qb, t_lo, NT, -slope * LOG2E, -Mb * LOG2E, Q, K, V, lds);
#endif
#pragma unroll
        for (int d = 0; d < 4; ++d)
#pragma unroll
            for (int r4 = 0; r4 < 4; ++r4) { const f32x4 s1 = *(const f32x4*)(stash + d * 16 + r4 * 4); f32x4 x;
#pragma unroll
                for (int i = 0; i < 4; ++i) { x[i] = s1[i] - lam * o[d][r4 * 4 + i]; ss[r4 * 4 + i] += x[i] * x[i]; }
                *(f32x4*)(stash + 64 + e * 64 + d * 16 + r4 * 4) = x; }
    }
#pragma unroll
    for (int r = 0; r < 16; ++r) {
#pragma unroll
        for (int off = 1; off < 32; off <<= 1) ss[r] += __shfl_xor(ss[r], off);
        ss[r] = (1.0f - LAM_INIT) / sqrtf(ss[r] * (1.0f / 256.0f) + EPS);
    }
    const float* sg = inptr(11);
    LAS bf16_t* stg = (LAS bf16_t*)(lds + wid * 16384);
#pragma unroll
    for (int e = 0; e < 2; ++e)
#pragma unroll
        for (int d = 0; d < 4; ++d) { const float gcol = sg[e * 128 + d * 32 + r32];
#pragma unroll
            for (int r4 = 0; r4 < 4; ++r4) { const f32x4 x = *(const f32x4*)(stash + 64 + e * 64 + d * 16 + r4 * 4);
#pragma unroll
                for (int i = 0; i < 4; ++i) stg[crow(r4 * 4 + i, hi) * 256 + e * 128 + d * 32 + r32] = (bf16_t)(cvt_pk_bf16(x[i] * ss[r4 * 4 + i] * gcol, 0.f) & 0xffffu); } }
    LDS_WAIT(); asm volatile("" ::: "memory");
    bf16_t* Ow = (bf16_t*)(P.ws + WS_O) + ((size_t)b * SEQ + qb * 256 + wid * 32) * DM + hidx * 256;
#pragma unroll 4
    for (int i = 0; i < 16; ++i) { const int row = 2 * i + (lane >> 5), ch = lane & 31;
        const u32x4 v = *(const LAS u32x4*)(stg + row * 256 + ch * 8); *(u32x4*)(Ow + (size_t)row * DM + ch * 8) = v; }
    LDS_WAIT(); VM_WAIT();
}
#undef PK4
#undef SBAR
#undef KSWZ
}

__device__ __forceinline__ unsigned f2bf(float f) { return cvt_pk_bf16(f, 0.f) & 0xffffu; }
__device__ __forceinline__ void p0_transpose_item(const float* W, int K, int N, bf16_t* WT, LAS float* scr, int item, int lane) {
    const int nblk = N / 32, kb = item / nblk, nb = item % nblk, k0 = 64 * kb, n0 = 32 * nb;
#pragma unroll 8
    for (int i = 0; i < 32; ++i) { const int kk = 2 * i + (lane >> 5); scr[kk * 33 + (lane & 31)] = W[(size_t)(k0 + kk) * N + n0 + (lane & 31)]; }
    LDS_WAIT(); asm volatile("" ::: "memory");
    const int c = lane & 7;
#pragma unroll
    for (int j = 0; j < 4; ++j) { const int n = (lane >> 3) + 8 * j; const LAS float* s = scr + (8 * c) * 33 + n;
        u32x4 o; o.x = cvt_pk_bf16(s[0 * 33], s[1 * 33]); o.y = cvt_pk_bf16(s[2 * 33], s[3 * 33]); o.z = cvt_pk_bf16(s[4 * 33], s[5 * 33]); o.w = cvt_pk_bf16(s[6 * 33], s[7 * 33]);
        *(u32x4*)(WT + (size_t)(n0 + n) * K + k0 + 8 * c) = o; }
    LDS_WAIT(); asm volatile("" ::: "memory");
}
__device__ __forceinline__ void p0_prologue(const Ptrs& P, LAS unsigned char* lds) {
    int tid_ = threadIdx.x; asm volatile("" : "+v"(tid_));
    const int tid = tid_, lane = tid & 63, wid = __builtin_amdgcn_readfirstlane(tid >> 6);
    const int gw = blockIdx.x * 8 + wid, NGW = gridDim.x * 8;
    LAS float* scr = (LAS float*)(lds + wid * 16384);
    unsigned char* ws = P.ws;
    constexpr int I_IN = (DM / 64) * (INW / 32), I_F = (1024 / 64) * (DM / 32), I_A = (DM / 64) * (DM / 32), I_O = I_A;
    for (int it = gw; it < I_IN + I_F + I_A + I_O; it += NGW) {
        int r = it;
        if (r < I_IN) { p0_transpose_item(inptr(2), DM, INW, (bf16_t*)(ws + WS_WTIN), scr, r, lane); continue; } r -= I_IN;
        if (r < I_F) { p0_transpose_item(inptr(3), 1024, DM, (bf16_t*)(ws + WS_WTF), scr, r, lane); continue; } r -= I_F;
        if (r < I_A) { p0_transpose_item(inptr(4), DM, DM, (bf16_t*)(ws + WS_WTA), scr, r, lane); continue; } r -= I_A;
        p0_transpose_item(inptr(12), DM, DM, (bf16_t*)(ws + WS_WTO), scr, r, lane);
    }
    const int gt = blockIdx.x * 512 + tid, NGT = gridDim.x * 512;
    { const float* wq = inptr(14); bf16_t* o = (bf16_t*)(ws + WS_WQ16);
      for (int i = gt; i < DM * DM / 8; i += NGT) { const f32x4 a = *(const f32x4*)(wq + (size_t)i * 8), b = *(const f32x4*)(wq + (size_t)i * 8 + 4); st8_bf16(o + (size_t)i * 8, a, b); } }
    { const float* sk = inptr(15); bf16_t* o = (bf16_t*)(ws + WS_SUBK);
      for (int i = gt; i < 8 * 256 * 256 / 8; i += NGT) { const int k8 = i & 31, r = (i >> 5) & 255, hh = i >> 13, c = r >> 7, key = r & 127, cp = (k8 * 8) >> 7, d = (k8 * 8) & 127;
          f32x4 a = {0.f, 0.f, 0.f, 0.f}, b = a;
          if (c == cp) { const float* s = sk + ((size_t)((hh * 2 + c) * 128 + key)) * 128 + d; a = *(const f32x4*)s; b = *(const f32x4*)(s + 4); }
          st8_bf16(o + (size_t)i * 8, a, b); } }
    { bf16_t* TT = (bf16_t*)(ws + WS_TT); bf16_t* F1 = (bf16_t*)(ws + WS_F1); bf16_t* F2 = (bf16_t*)(ws + WS_F2);
      for (int i = gt; i < 65536; i += NGT) {
          { const int jp = i >> 8, j = i & 255; float v;
            if (jp <= 128) v = __builtin_amdgcn_cosf((float)((j * jp) & 255) * (1.0f / 256.0f)); else v = -__builtin_amdgcn_sinf((float)((j * (jp - 128)) & 255) * (1.0f / 256.0f));
            TT[i] = (bf16_t)f2bf(v * (1.0f / 16.0f)); }
          { const int rr = i >> 8, cc = i & 255, rip = rr >> 7, k1 = rr & 127, ri = cc >> 7, n1 = cc & 127; const float ph = (float)((n1 * k1) & 127) * (1.0f / 128.0f);
            const float cs = __builtin_amdgcn_cosf(ph), sn = __builtin_amdgcn_sinf(ph);
            const float v = (rip == 0) ? (ri == 0 ? cs : sn) : (ri == 0 ? -sn : cs);
            F1[i] = (bf16_t)f2bf(v * 0.08838834764831845f); }
          if (i < 32768) { const int k2 = i >> 7, cc = i & 127, ri = cc >> 6, n2 = cc & 63; float v = 0.f;
            if (k2 < 64) { const float ph = (float)((n2 * k2) & 63) * (1.0f / 64.0f); v = (ri == 0 ? __builtin_amdgcn_cosf(ph) : __builtin_amdgcn_sinf(ph)) * 0.125f; }
            F2[i] = (bf16_t)f2bf(v); }
      } }
    { const float* g1 = inptr(1); f32x4 gv[8];
#pragma unroll
      for (int j = 0; j < 8; ++j) gv[j] = *(const f32x4*)(g1 + (64 * j + lane) * 4);
      for (int m = gw; m < NTOK; m += NGW) {
          const f32x4* xr = (const f32x4*)(inptr(0) + (size_t)m * DM) + lane; f32x4 v[8]; float s = 0.f;
#pragma unroll
          for (int j = 0; j < 8; ++j) { v[j] = xr[64 * j]; s += (v[j][0] * v[j][0] + v[j][1] * v[j][1]) + (v[j][2] * v[j][2] + v[j][3] * v[j][3]); }
          const float rstd = 1.0f / sqrtf(wave_sum(s) * (1.0f / DM) + EPS);
          u32x2* o8 = (u32x2*)((bf16_t*)(ws + WS_XN) + (size_t)m * DM) + lane;
#pragma unroll
          for (int j = 0; j < 8; ++j) { const f32x4 y = v[j] * rstd * gv[j]; u32x2 w; w.x = cvt_pk_bf16(y[0], y[1]); w.y = cvt_pk_bf16(y[2], y[3]); o8[64 * j] = w; }
      } }
}
__device__ __forceinline__ void convert_experts(const Ptrs& P) {
    int tid_ = threadIdx.x; asm volatile("" : "+v"(tid_));
    const int gt = blockIdx.x * 512 + tid_, NGT = gridDim.x * 512;
    const float* eu = inptr(16); const float* ev = inptr(17); bf16_t* ou = (bf16_t*)(P.ws + WS_EU); bf16_t* ov = (bf16_t*)(P.ws + WS_EV);
    constexpr int N8 = 16384 * 2048 / 8;
    for (int i = gt; i < 2 * N8; i += NGT) {
        const bool first = i < N8; const int j = first ? i : i - N8; const float* s = (first ? eu : ev) + (size_t)j * 8;
        const f32x4 a = *(const f32x4*)s, b = *(const f32x4*)(s + 4); st8_bf16((first ? ou : ov) + (size_t)j * 8, a, b);
    }
}

namespace peer {
__device__ __forceinline__ unsigned f2key(float f) { const unsigned u = __float_as_uint(f); return (u & 0x80000000u) ? ~u : (u | 0x80000000u); }
__device__ __forceinline__ float key2f(unsigned k) { const unsigned u = (k & 0x80000000u) ? (k & 0x7fffffffu) : ~k; return __uint_as_float(u); }
template <int CTRL> __device__ __forceinline__ unsigned dppu(unsigned x) { return (unsigned)__builtin_amdgcn_update_dpp(0, (int)x, CTRL, 0xF, 0xF, false); }
__device__ __forceinline__ unsigned umax_(unsigned a, unsigned b) { return a > b ? a : b; }
__device__ __forceinline__ unsigned rowmax16(unsigned x) {
    x = umax_(x, dppu<0xB1>(x)); x = umax_(x, dppu<0x4E>(x)); x = umax_(x, dppu<0x141>(x)); x = umax_(x, dppu<0x140>(x)); return x;
}
__device__ __forceinline__ float gelu_erf(float v) { return 0.5f * v * (1.0f + erff(v * 0.70710678118654752f)); }

__device__ __forceinline__ void peer_phase(const Ptrs& P, LAS unsigned char* lds) {
    int tid_ = threadIdx.x; asm volatile("" : "+v"(tid_));
    const int tid = tid_, lane = tid & 63, wid = __builtin_amdgcn_readfirstlane(tid >> 6);
    const int gw = blockIdx.x * 8 + wid, NGW = gridDim.x * 8;
    LAS int* pidx = (LAS int*)(lds + wid * 1024); LAS float* pgate = (LAS float*)(lds + wid * 1024 + 512);
    const float* SC = (const float*)(P.ws + WS_SC); const bf16_t* EU = (const bf16_t*)(P.ws + WS_EU); const bf16_t* EV = (const bf16_t*)(P.ws + WS_EV);
    const float* g2 = inptr(13); float* OUT = P.out;
    int ci = 0, cj = 0; bool cvalid = false;
    { int pre = 0;
      for (int i = 0; i < 16; ++i) { const int cnt = 16 / (i + 1); if (lane >= pre && lane < pre + cnt) { ci = i; cj = lane - pre; cvalid = true; } pre += cnt; } }
    const int half = lane >> 5, li = lane & 31;
    for (int tok = gw; tok < NTOK; tok += NGW) {
        unsigned hnp[16]; float rstd;
        { const float* hp = OUT + (size_t)tok * DM; f32x4 hv[8]; float s = 0.f;
#pragma unroll
          for (int j = 0; j < 4; ++j) { hv[2 * j] = *(const f32x4*)(hp + 512 * j + 8 * lane); hv[2 * j + 1] = *(const f32x4*)(hp + 512 * j + 8 * lane + 4); }
#pragma unroll
          for (int j = 0; j < 8; ++j) s += (hv[j][0] * hv[j][0] + hv[j][1] * hv[j][1]) + (hv[j][2] * hv[j][2] + hv[j][3] * hv[j][3]);
          rstd = 1.0f / sqrtf(wave_sum(s) * (1.0f / DM) + EPS);
#pragma unroll
          for (int j = 0; j < 4; ++j) { const f32x4 ga = *(const f32x4*)(g2 + 512 * j + 8 * lane), gb = *(const f32x4*)(g2 + 512 * j + 8 * lane + 4);
              const f32x4 a = hv[2 * j] * rstd * ga, b = hv[2 * j + 1] * rstd * gb;
              hnp[4 * j + 0] = cvt_pk_bf16(a[0], a[1]); hnp[4 * j + 1] = cvt_pk_bf16(a[2], a[3]); hnp[4 * j + 2] = cvt_pk_bf16(b[0], b[1]); hnp[4 * j + 3] = cvt_pk_bf16(b[2], b[3]); } }
        for (int hh = 0; hh < 8; ++hh) {
            const f32x4 sc = *(const f32x4*)(SC + (size_t)tok * DM + hh * 256 + half * 128 + li * 4);
            unsigned k0 = (f2key(sc[0]) & ~0x7Fu) | (unsigned)(127 - (li * 4 + 0)), k1 = (f2key(sc[1]) & ~0x7Fu) | (unsigned)(127 - (li * 4 + 1));
            unsigned k2 = (f2key(sc[2]) & ~0x7Fu) | (unsigned)(127 - (li * 4 + 2)), k3 = (f2key(sc[3]) & ~0x7Fu) | (unsigned)(127 - (li * 4 + 3));
            unsigned selA = 0u;
            for (int r = 0; r < 16; ++r) {
                unsigned m = umax_(umax_(k0, k1), umax_(k2, k3)); m = rowmax16(m);
                const unsigned s0 = __builtin_amdgcn_readlane(m, 0), s1 = __builtin_amdgcn_readlane(m, 16), s2 = __builtin_amdgcn_readlane(m, 32), s3 = __builtin_amdgcn_readlane(m, 48);
                const unsigned M0 = umax_(s0, s1), M1 = umax_(s2, s3); const unsigned Mh = half ? M1 : M0;
                k0 = (k0 == Mh) ? 0u : k0; k1 = (k1 == Mh) ? 0u : k1; k2 = (k2 == Mh) ? 0u : k2; k3 = (k3 == Mh) ? 0u : k3;
                selA = (li == r) ? Mh : selA;
            }
            const unsigned ka = (unsigned)__shfl((int)selA, ci), kb = (unsigned)__shfl((int)selA, 32 + cj);
            const float csum = key2f(ka & ~0x7Fu) + key2f(kb & ~0x7Fu);
            unsigned ck = cvalid ? ((f2key(csum) & ~0xFFu) | (unsigned)(255 - (ci * 16 + cj))) : 0u;
            unsigned selC = 0u;
            for (int r = 0; r < 16; ++r) {
                const unsigned m = rowmax16(ck);
                const unsigned s0 = __builtin_amdgcn_readlane(m, 0), s1 = __builtin_amdgcn_readlane(m, 16), s2 = __builtin_amdgcn_readlane(m, 32), s3 = __builtin_amdgcn_readlane(m, 48);
                const unsigned Mx = umax_(umax_(s0, s1), umax_(s2, s3));
                ck = (ck == Mx) ? 0u : ck; selC = (lane == r) ? Mx : selC;
            }
            const int flat = 255 - (int)(selC & 0xFFu), fi = (flat >> 4) & 15, fj = flat & 15;
            const unsigned ea = (unsigned)__shfl((int)selA, fi), eb = (unsigned)__shfl((int)selA, 32 + fj);
            const int eidx = (127 - (int)(ea & 0x7Fu)) * 128 + (127 - (int)(eb & 0x7Fu));
            const float sv = key2f(selC & ~0xFFu) * rstd;
            const float smax = __shfl(sv, 0);
            float e = (lane < 16) ? __expf(sv - smax) : 0.f;
            float es = e; es += __shfl_xor(es, 1); es += __shfl_xor(es, 2); es += __shfl_xor(es, 4); es += __shfl_xor(es, 8);
            if (lane < 16) { pidx[hh * 16 + lane] = eidx; pgate[hh * 16 + lane] = e / es; }
        }
        LDS_WAIT(); asm volatile("" ::: "memory");
        const int idxA = pidx[lane], idxB = pidx[64 + lane]; const float gA = pgate[lane], gB = pgate[64 + lane];
        LDS_WAIT(); asm volatile("" ::: "memory");
        float dotA = 0.f, dotB = 0.f;
        for (int eb = 0; eb < 32; ++eb) {
            u32x4 w[4][4];
#pragma unroll
            for (int i = 0; i < 4; ++i) { const int e = eb * 4 + i; const int row = (e < 64) ? __builtin_amdgcn_readlane(idxA, e & 63) : __builtin_amdgcn_readlane(idxB, e & 63);
                const bf16_t* rp = EU + (size_t)row * DM + 8 * lane;
#pragma unroll
                for (int j = 0; j < 4; ++j) w[i][j] = *(const u32x4*)(rp + 512 * j); }
#pragma unroll
            for (int i = 0; i < 4; ++i) { const int e = eb * 4 + i; float p = 0.f;
#pragma unroll
                for (int j = 0; j < 4; ++j) {
#pragma unroll
                    for (int x = 0; x < 4; ++x) { const unsigned a = w[i][j][x], hb = hnp[4 * j + x]; p = __builtin_fmaf(bf_lo(a), bf_lo(hb), p); p = __builtin_fmaf(bf_hi(a), bf_hi(hb), p); } }
                p = wave_sum(p);
                if (e < 64) dotA = (lane == (e & 63)) ? p : dotA; else dotB = (lane == (e & 63)) ? p : dotB; }
        }
        const float actA = gelu_erf(dotA) * gA, actB = gelu_erf(dotB) * gB;
        float acc[32];
#pragma unroll
        for (int i = 0; i < 32; ++i) acc[i] = 0.f;
        for (int eb = 0; eb < 32; ++eb) {
            u32x4 w[4][4]; float av[4];
#pragma unroll
            for (int i = 0; i < 4; ++i) { const int e = eb * 4 + i; const int row = (e < 64) ? __builtin_amdgcn_readlane(idxA, e & 63) : __builtin_amdgcn_readlane(idxB, e & 63);
                av[i] = (e < 64) ? __uint_as_float(__builtin_amdgcn_readlane(__float_as_uint(actA), e & 63)) : __uint_as_float(__builtin_amdgcn_readlane(__float_as_uint(actB), e & 63));
                const bf16_t* rp = EV + (size_t)row * DM + 8 * lane;
#pragma unroll
                for (int j = 0; j < 4; ++j) w[i][j] = *(const u32x4*)(rp + 512 * j); }
#pragma unroll
            for (int i = 0; i < 4; ++i)
#pragma unroll
                for (int j = 0; j < 4; ++j)
#pragma unroll
                    for (int x = 0; x < 4; ++x) { const unsigned a = w[i][j][x]; acc[8 * j + 2 * x] = __builtin_fmaf(av[i], bf_lo(a), acc[8 * j + 2 * x]); acc[8 * j + 2 * x + 1] = __builtin_fmaf(av[i], bf_hi(a), acc[8 * j + 2 * x + 1]); }
        }
        { float* hp = OUT + (size_t)tok * DM;
#pragma unroll
          for (int j = 0; j < 4; ++j) { f32x4 a = *(const f32x4*)(hp + 512 * j + 8 * lane), b = *(const f32x4*)(hp + 512 * j + 8 * lane + 4);
              a += (f32x4){acc[8 * j + 0], acc[8 * j + 1], acc[8 * j + 2], acc[8 * j + 3]}; b += (f32x4){acc[8 * j + 4], acc[8 * j + 5], acc[8 * j + 6], acc[8 * j + 7]};
              *(f32x4*)(hp + 512 * j + 8 * lane) = a; *(f32x4*)(hp + 512 * j + 8 * lane + 4) = b; } }
    }
}
}

struct KArgs { const float* in[18]; float* out; unsigned char* ws; int ph_lo, ph_hi; };
#ifndef DBG_NPH
#define DBG_NPH 9
#endif
constexpr int NPHASE = DBG_NPH;

__global__ void __launch_bounds__(512, 2) enc_fwd(KArgs args) {
    extern __shared__ __attribute__((aligned(16))) unsigned char lds_raw[];
    LAS unsigned char* lds = (LAS unsigned char*)lds_raw;
    const int lo = args.ph_lo, hi = args.ph_hi;
    Ptrs P; P.ws = args.ws; P.out = args.out;
    const int G = gridDim.x, c = blockIdx.x;
#ifndef PHASE_MASK
#define PHASE_MASK 0x1ff
#endif
#define IN(k) (((PHASE_MASK >> (k)) & 1) && lo <= (k) && (k) < hi)
#define SEAM(k) do { if (lo <= (k) && (k) + 1 < hi) { __threadfence(); cg::this_grid().sync(); } } while (0)
#define RUN_RM(KIND) do { Sched<KIND> S{G, c, P.ws}; EpiRM<KIND> E{P}; g8::gemm_phase<EpiRM<KIND>, Sched<KIND>>(lds, geo_of(KIND), S, E); } while (0)
#define RUN_T(KIND) do { Sched<KIND> S{G, c, P.ws}; EpiT<KIND> E{P}; g8::gemm_phase<EpiT<KIND>, Sched<KIND>>(lds, geo_of(KIND), S, E); } while (0)
    if (IN(0)) p0_prologue(P, lds);
    SEAM(0);
    if (IN(1)) { RUN_RM(K_INPROJ); VM_WAIT(); __syncthreads(); RUN_RM(K_FOLD); }
    SEAM(1);
    if (IN(2)) RUN_T(K_STEPA);
    SEAM(2);
    if (IN(3)) RUN_T(K_STAGE1);
    SEAM(3);
    if (IN(4)) {
#ifndef DBG_NO_ST2
        RUN_T(K_STAGE2); VM_WAIT(); __syncthreads();
#endif
        const int lane = threadIdx.x & 63;
        const float s1 = wave_sum(inptr(7)[lane] * inptr(8)[lane] + inptr(7)[lane + 64] * inptr(8)[lane + 64]);
        const float s2 = wave_sum(inptr(9)[lane] * inptr(10)[lane] + inptr(9)[lane + 64] * inptr(10)[lane + 64]);
        const float lam = __expf(s1) - __expf(s2) + LAM_INIT;
        const float mq = wave_max(fmaxf(fabsf(inptr(5)[lane]), fabsf(inptr(5)[lane + 64]))), mk = wave_max(fmaxf(fabsf(inptr(6)[lane]), fabsf(inptr(6)[lane + 64])));
        const float Mb = 11.313708498984761f * mq * mk * 1.01f;
        unsigned* qhead = (unsigned*)(P.ws + WS_CTL) + CW_ATTQ;
        LAS int* ubox = (LAS int*)(lds + att::L_WS + 2048 - 16);
#ifndef DBG_NO_ATT
        for (;;) {
            if (threadIdx.x == 0) ubox[0] = (int)atomicAdd(qhead, 1u);
            __syncthreads();
            const int unit = __builtin_amdgcn_readfirstlane(ubox[0]);
            __syncthreads();
            if (unit >= 512) break;
            att::attn_unit(unit, P, lds, lam, Mb);
        }
#endif
    }
    SEAM(4);
    if (IN(5)) { convert_experts(P); RUN_RM(K_YA); VM_WAIT(); __syncthreads(); RUN_RM(K_YF); }
    SEAM(5);
    if (IN(6)) RUN_RM(K_OUT);
    SEAM(6);
    if (IN(7)) RUN_RM(K_SC);
    SEAM(7);
    if (IN(8)) peer::peer_phase(P, lds);
}

extern "C" void kernel_launch(void* const* d_in, const int* in_sizes, int n_in, void* d_out, int out_size, void* d_ws, size_t ws_size, hipStream_t stream) {
    static int grid = 0;
    if (grid == 0) {
        if (n_in != 18 || in_sizes[0] != NTOK * DM || out_size != NTOK * DM || ws_size < WS_END) {
            fprintf(stderr, "kernel_launch: shape mismatch (n_in %d, in0 %d, out %d, ws %zu)\n", n_in, n_in > 0 ? in_sizes[0] : -1, out_size, ws_size); grid = -1; return; }
        int dev = 0, cus = 0, per_cu = 0;
        hipGetDevice(&dev); hipDeviceGetAttribute(&cus, hipDeviceAttributeMultiprocessorCount, dev);
        if (hipFuncSetAttribute((const void*)enc_fwd, hipFuncAttributeMaxDynamicSharedMemorySize, LDS_BYTES) != hipSuccess) { fprintf(stderr, "kernel_launch: hipFuncSetAttribute failed\n"); grid = -1; return; }
        if (hipOccupancyMaxActiveBlocksPerMultiprocessor(&per_cu, (const void*)enc_fwd, 512, LDS_BYTES) != hipSuccess || per_cu < 1) { fprintf(stderr, "kernel_launch: occupancy query gives %d\n", per_cu); per_cu = 1; }
        (void)hipGetLastError();
        grid = cus;
    }
    if (grid < 0) return;
    hipMemsetAsync((char*)d_ws + WS_CTL, 0, CTL_BYTES, stream);
    KArgs a{};
    for (int i = 0; i < 18; ++i) a.in[i] = (const float*)d_in[i];
    a.out = (float*)d_out; a.ws = (unsigned char*)d_ws;
#if MK_ONE_LAUNCH
    a.ph_lo = 0; a.ph_hi = NPHASE;
    void* kargs[] = {&a};
    hipError_t e = hipLaunchCooperativeKernel((const void*)enc_fwd, dim3(grid), dim3(512), kargs, LDS_BYTES, stream);
    if (e != hipSuccess) fprintf(stderr, "cooperative launch failed: %s (grid %d)\n", hipGetErrorString(e), grid);
#else
    for (int ph = 0; ph < NPHASE; ++ph) {
        a.ph_lo = ph; a.ph_hi = ph + 1;
        hipLaunchKernelGGL(enc_fwd, dim3(grid), dim3(512), LDS_BYTES, stream, a);
    }
    const hipError_t le = hipPeekAtLastError();
    if (le != hipSuccess) fprintf(stderr, "kernel_launch: launch failed: %s\n", hipGetErrorName(le));
#endif
}
```

```cpp
#include <hip/hip_runtime.h>
#include <hip/hip_cooperative_groups.h>
#include <cstdio>
#include <cstdint>
namespace cg = cooperative_groups;


#ifndef MK_ONE_LAUNCH
#define MK_ONE_LAUNCH 1
#endif

#define LAS __attribute__((address_space(3)))
typedef unsigned short bf16_t;
typedef short bf16x8 __attribute__((ext_vector_type(8)));
typedef short s16x4 __attribute__((ext_vector_type(4)));
typedef float f32x4 __attribute__((ext_vector_type(4)));
typedef float f32x16 __attribute__((ext_vector_type(16)));
typedef unsigned u32x4 __attribute__((ext_vector_type(4)));
typedef int i32x8 __attribute__((ext_vector_type(8)));
typedef unsigned u32x2 __attribute__((ext_vector_type(2)));

constexpr int NTOK = 16384, DM = 2048, SEQ = 8192, NBATCH = 2, INW = 11264;
constexpr float EPS = 1e-6f;
constexpr float LAM_INIT = 0.2f;
constexpr float LOG2E = 1.4426950408889634f;
constexpr int NKC = 129;

constexpr size_t MiB = 1u << 20;
constexpr size_t WS_CTL = 0, CTL_BYTES = 65536;
constexpr size_t WS_TT = 1 * MiB + 64 * 1024, WS_F1 = 1 * MiB + 192 * 1024, WS_F2 = 1 * MiB + 320 * 1024;
constexpr size_t WS_ESC = 1 * MiB + 512 * 1024;
constexpr size_t WS_SUBK = 2 * MiB;
constexpr size_t WS_WTIN = 4 * MiB, WS_A1 = WS_WTIN;
constexpr size_t WS_EU = WS_WTIN, WS_EV = WS_WTIN + 16 * MiB;
constexpr size_t WS_WTF = 48 * MiB, WS_WTA = 52 * MiB, WS_WTO = 60 * MiB, WS_WQ16 = 68 * MiB, WS_WTS = 76 * MiB;
constexpr size_t WS_XN = 84 * MiB, WS_A2 = WS_XN, WS_MIXED = WS_XN;
constexpr size_t WS_ZF = 148 * MiB, WS_YF = WS_ZF;
constexpr size_t WS_Q = 180 * MiB, WS_O = WS_Q, WS_HG = WS_Q;
constexpr size_t WS_XN8 = 180 * MiB, WS_WG8 = 212 * MiB;
constexpr size_t WS_K = 244 * MiB, WS_Q8 = WS_K + 32 * MiB;
constexpr size_t WS_V = 308 * MiB;
constexpr size_t WS_GF = 372 * MiB, WS_SC = WS_GF;
constexpr size_t WS_GA = 436 * MiB;
constexpr size_t WS_END = 500 * MiB;
constexpr int CW_ATTQ = 64;
constexpr int CW_GMAX = 704;
constexpr int CW_CVTQ = 640;
constexpr int CW_BAR = 1024;

constexpr int RING_BYTES = 131072;
constexpr int EPI_OFF = RING_BYTES;
constexpr int LDS_BYTES = 163840;

__device__ __forceinline__ unsigned cvt_pk_bf16(float lo, float hi) { unsigned r; asm volatile("v_cvt_pk_bf16_f32 %0, %1, %2" : "=v"(r) : "v"(lo), "v"(hi)); return r; }
__device__ __forceinline__ float bf_lo(unsigned w) { return __uint_as_float(w << 16); }
__device__ __forceinline__ float bf_hi(unsigned w) { return __uint_as_float(w & 0xffff0000u); }
__device__ __forceinline__ float wave_sum(float v) {
#pragma unroll
    for (int o = 1; o < 64; o <<= 1) v += __shfl_xor(v, o);
    return v;
}
__device__ __forceinline__ float wave_max(float v) {
#pragma unroll
    for (int o = 1; o < 64; o <<= 1) v = fmaxf(v, __shfl_xor(v, o));
    return v;
}
#define LDS_WAIT() asm volatile("s_waitcnt lgkmcnt(0)" ::: "memory")
#define VM_WAIT() asm volatile("s_waitcnt vmcnt(0)" ::: "memory")

__device__ __forceinline__ void glds16_(const void* gbase, unsigned voff, unsigned lds_dst) { unsigned keep;
    asm volatile("s_mov_b32 %0, m0\n\ts_mov_b32 m0, %3\n\ts_nop 0\n\tglobal_load_lds_dwordx4 %1, %2\n\ts_mov_b32 m0, %0" : "=&s"(keep) : "v"(voff), "s"(gbase), "s"(lds_dst) : "memory"); }
namespace g8 {
constexpr int BM = 256, BK = 64, HALF = 128, HTB = HALF * BK * 2;
__host__ __device__ __forceinline__ int lds_byte(int r, int c) { const int st = (r >> 4) * 2 + (c >> 5), rr = r & 15, cc = c & 31, ob = rr * 64 + cc * 2; return st * 1024 + (ob ^ (((ob >> 9) & 1) << 5)); }
__host__ __device__ __forceinline__ void stage_rc(int b, int& R, int& C) { const int st = b / 1024, sb = b % 1024, swz = sb ^ (((sb >> 9) & 1) << 5); R = (st >> 1) * 16 + swz / 64; C = (st & 1) * 32 + (swz % 64) / 2; }
__host__ __device__ __forceinline__ int perm32(int rho) { const int n = rho >> 4, i = rho & 15; return 8 * (i >> 2) + 4 * n + (i & 3); }

struct Unit { const char* a; const char* b; int pm, pn, aux; };
struct Geo { int K; unsigned rowA, halfA, rowB, halfB; };

template <class Epi, class Sched>
__device__ __forceinline__ void gemm_phase(LAS unsigned char* lds, const Geo g, const Sched& S, const Epi& E, int wid0) {
    int tid_ = wid0 * 64 + (int)__builtin_amdgcn_mbcnt_hi(~0u, __builtin_amdgcn_mbcnt_lo(~0u, 0u)); asm volatile("" : "+v"(tid_));
    const int tid = tid_, wid = __builtin_amdgcn_readfirstlane(tid >> 6), lane = tid & 63, wr = wid >> 2, wc = wid & 3, fr = lane & 15, fq = lane >> 4;
    const int nt = g.K / BK;
    unsigned voffA[2], voffB[2];
#pragma unroll
    for (int i = 0; i < 2; ++i) { int R, C; stage_rc(tid * 16 + i * 8192, R, C); const int Rb = Epi::PERM ? ((R & ~31) + perm32(R & 31)) : R;
        voffA[i] = (unsigned)R * g.rowA + (unsigned)C * 2u; voffB[i] = (unsigned)Rb * g.rowB + (unsigned)C * 2u; }
    const size_t kstep = (size_t)(BK * 2);
    const size_t hA = g.halfA, hB = g.halfB;
    const unsigned ldsw = (unsigned)wid * 1024u; const unsigned ldsb = (unsigned)__builtin_amdgcn_readfirstlane((int)((unsigned)(size_t)lds + ldsw));
    const int aoff = lds_byte(wr * 64 + fr, fq * 8), boff = lds_byte(wc * 32 + fr, fq * 8);
#define G8_SA(b, h) (((b) * 2 + (h)) * HTB)
#define G8_SB(b, h) ((4 + (b) * 2 + (h)) * HTB)
#define G8_STAGE(bufoff, gbase, voff) do { _Pragma("unroll") for (int _i = 0; _i < 2; ++_i) \
        glds16_((const char*)(gbase), (voff)[_i], ldsb + (unsigned)((bufoff) + _i * 8192)); } while (0)
#define G8_LDA(dst, b, h) do { _Pragma("unroll") for (int m = 0; m < 4; ++m) _Pragma("unroll") for (int k = 0; k < 2; ++k) dst[m][k] = *(const LAS bf16x8*)(lds + G8_SA(b, h) + aoff + m * 2048 + k * 1024); } while (0)
#define G8_LDB(dst, b, h) do { _Pragma("unroll") for (int n = 0; n < 2; ++n) _Pragma("unroll") for (int k = 0; k < 2; ++k) dst[n][k] = *(const LAS bf16x8*)(lds + G8_SB(b, h) + boff + n * 2048 + k * 1024); } while (0)
#define G8_P8(X0, X1) ([&]() { const u32x4 a_ = __builtin_bit_cast(u32x4, X0), b_ = __builtin_bit_cast(u32x4, X1); return (i32x8){(int)a_[0], (int)a_[1], (int)a_[2], (int)a_[3], (int)b_[0], (int)b_[1], (int)b_[2], (int)b_[3]}; }())
#define G8_MMA(ai, bj, At, Bt) do { __builtin_amdgcn_s_setprio(1); \
        if constexpr (Epi::FP8) { _Pragma("unroll") for (int m = 0; m < 4; ++m) _Pragma("unroll") for (int n = 0; n < 2; ++n) \
            acc[ai][bj][m][n] = __builtin_amdgcn_mfma_scale_f32_16x16x128_f8f6f4(G8_P8(Bt[n][0], Bt[n][1]), G8_P8(At[m][0], At[m][1]), acc[ai][bj][m][n], 0, 0, 0, 0, 0, 0); } \
        else { _Pragma("unroll") for (int m = 0; m < 4; ++m) _Pragma("unroll") for (int n = 0; n < 2; ++n) _Pragma("unroll") for (int k = 0; k < 2; ++k) \
        acc[ai][bj][m][n] = Epi::SWAP ? __builtin_amdgcn_mfma_f32_16x16x32_bf16(Bt[n][k], At[m][k], acc[ai][bj][m][n], 0, 0, 0) \
                                      : __builtin_amdgcn_mfma_f32_16x16x32_bf16(At[m][k], Bt[n][k], acc[ai][bj][m][n], 0, 0, 0); } __builtin_amdgcn_s_setprio(0); } while (0)
#define G8_WAIT_V(n) asm volatile("s_waitcnt vmcnt(" #n ")" ::: "memory")
#define G8_WAIT_L(n) asm volatile("s_waitcnt lgkmcnt(" #n ")" ::: "memory")
#define G8_BAR __builtin_amdgcn_s_barrier()
#define G8_SCHED __builtin_amdgcn_sched_barrier(0)
    Unit cur, nxt; int ui = 0;
    if (!S.next(0, cur)) return;
    f32x4 acc[2][2][4][2];
#pragma unroll
    for (int a = 0; a < 2; ++a)
#pragma unroll
        for (int b = 0; b < 2; ++b)
#pragma unroll
            for (int m = 0; m < 4; ++m)
#pragma unroll
                for (int n = 0; n < 2; ++n) acc[a][b][m][n] = (f32x4){0.f, 0.f, 0.f, 0.f};
    bf16x8 At[4][2], B0[2][2], B1[2][2];
    const char* cA = cur.a; const char* cB = cur.b;
    G8_STAGE(G8_SB(0, 0), cB, voffB); G8_STAGE(G8_SB(0, 1), cB + hB, voffB); G8_STAGE(G8_SA(0, 0), cA, voffA); G8_STAGE(G8_SA(0, 1), cA + hA, voffA);
    if (wr == 1) G8_BAR;
    G8_WAIT_V(2); G8_BAR;
    G8_STAGE(G8_SB(1, 0), cB + kstep, voffB); G8_STAGE(G8_SA(1, 0), cA + kstep, voffA); G8_STAGE(G8_SB(1, 1), cB + hB + kstep, voffB);
    G8_WAIT_V(6); G8_BAR;
    for (;;) {
        const bool has_next = S.next(ui + 1, nxt);
        const char* nA = has_next ? nxt.a : cA; const char* nB = has_next ? nxt.b : cB;
        for (int t = 0; t < nt; t += 2) {
            const bool last = (t == nt - 2);
            const char* a1 = cA + (size_t)(t + 1) * kstep;
            const char* a2 = last ? nA : cA + (size_t)(t + 2) * kstep; const char* b2 = last ? nB : cB + (size_t)(t + 2) * kstep;
            const char* a3 = a2 + kstep; const char* b3 = b2 + kstep;
            G8_LDB(B0, 0, 0); G8_LDB(B1, 0, 1); G8_SCHED; G8_LDA(At, 0, 0); G8_STAGE(G8_SA(1, 1), a1 + hA, voffA);
            G8_WAIT_V(8); G8_WAIT_L(0); G8_BAR; G8_MMA(0, 0, At, B0); G8_MMA(0, 1, At, B1); G8_BAR; G8_SCHED;
            G8_LDA(At, 0, 1); G8_STAGE(G8_SB(0, 0), b2, voffB); G8_STAGE(G8_SB(0, 1), b2 + hB, voffB); G8_STAGE(G8_SA(0, 0), a2, voffA);
            G8_WAIT_V(8); G8_WAIT_L(0); G8_BAR; G8_MMA(1, 0, At, B0); G8_MMA(1, 1, At, B1); G8_BAR; G8_SCHED;
            G8_LDB(B0, 1, 0); G8_LDB(B1, 1, 1); G8_SCHED; G8_LDA(At, 1, 0); G8_STAGE(G8_SA(0, 1), a2 + hA, voffA);
            G8_WAIT_V(8); G8_WAIT_L(0); G8_BAR; G8_MMA(0, 0, At, B0); G8_MMA(0, 1, At, B1); G8_BAR; G8_SCHED;
            G8_LDA(At, 1, 1); G8_STAGE(G8_SB(1, 0), b3, voffB); G8_STAGE(G8_SB(1, 1), b3 + hB, voffB); G8_STAGE(G8_SA(1, 0), a3, voffA);
            G8_WAIT_V(8); G8_WAIT_L(0); G8_BAR; G8_MMA(1, 0, At, B0); G8_MMA(1, 1, At, B1); G8_BAR; G8_SCHED;
        }
        if (wr == 0) G8_BAR;
        E(acc, cur, wr, wc, fr, fq, lds + EPI_OFF);
        if (!has_next) break;
#pragma unroll
        for (int a = 0; a < 2; ++a)
#pragma unroll
            for (int b = 0; b < 2; ++b)
#pragma unroll
                for (int m = 0; m < 4; ++m)
#pragma unroll
                    for (int n = 0; n < 2; ++n) acc[a][b][m][n] = (f32x4){0.f, 0.f, 0.f, 0.f};
        cur = nxt; cA = nA; cB = nB; ++ui;
        if (wr == 1) G8_BAR;
    }
    G8_WAIT_V(0);
    G8_BAR;
#undef G8_SA
#undef G8_SB
#undef G8_STAGE
#undef G8_LDA
#undef G8_LDB
#undef G8_MMA
#undef G8_P8
}
}

enum { K_INPROJ = 0, K_FOLD, K_YA, K_YF, K_OUT, K_SC, K_STEPA, K_STAGE1, K_STAGE2, K_GATE8 };

struct Ptrs { float* out; unsigned char* ws; int wid0; };
__device__ __forceinline__ int lane_id() { return (int)__builtin_amdgcn_mbcnt_hi(~0u, __builtin_amdgcn_mbcnt_lo(~0u, 0u)); }
__device__ __forceinline__ const float* inptr(int i) {
    const __attribute__((address_space(4))) char* kp = (const __attribute__((address_space(4))) char*)__builtin_amdgcn_kernarg_segment_ptr();
    return *(const float* const __attribute__((address_space(4)))*)(kp + i * 8);
}

__device__ __forceinline__ void tile_order(int L, int nM, int nN, int& pm, int& pn) {
    const int nwg = nM * nN; constexpr int NXCD = 8, WGM = 8;
    int wgid = L; { const int q = nwg / NXCD, r = nwg % NXCD, xcd = wgid % NXCD, off = wgid / NXCD; wgid = (xcd < r ? xcd * (q + 1) : r * (q + 1) + (xcd - r) * q) + off; }
    const int nig = WGM * nN, gid = wgid / nig, fm = gid * WGM, gsz = (nM - fm) < WGM ? (nM - fm) : WGM;
    pm = fm + ((wgid % nig) % gsz); pn = (wgid % nig) / gsz;
}

template <int kind> struct Sched {
    int G, c; unsigned char* ws;
    __device__ __forceinline__ bool next(int i, g8::Unit& u) const {
        const int L = i * G + c;
        switch (kind) {
        case K_GATE8: { if (L >= 64 * 16) return false; tile_order(L, 64, 16, u.pm, u.pn);
            u.a = (const char*)(ws + WS_XN8) + (size_t)u.pm * 256 * DM; u.b = (const char*)(ws + WS_WG8) + (size_t)u.pn * 256 * DM; u.aux = 0; return true; }
        case K_INPROJ: { if (L >= 64 * 28) return false; tile_order(L, 64, 28, u.pm, u.pn);
            u.a = (const char*)(ws + WS_XN) + (size_t)u.pm * 256 * DM * 2; u.b = (const char*)(ws + WS_WTIN) + (size_t)u.pn * 256 * DM * 2; u.aux = 0; return true; }
        case K_FOLD: { if (L >= 64) return false; u.pm = L >> 3; u.pn = L & 7;
            u.a = (const char*)(ws + WS_SUBK) + (size_t)u.pm * 256 * 256 * 2; u.b = (const char*)(ws + WS_WQ16) + ((size_t)u.pn * 256 * DM + (size_t)u.pm * 256) * 2; u.aux = 0; return true; }
        case K_YA: { if (L >= 512) return false; tile_order(L, 64, 8, u.pm, u.pn);
            u.a = (const char*)(ws + WS_O) + (size_t)u.pm * 256 * DM * 2; u.b = (const char*)(ws + WS_WTA) + (size_t)u.pn * 256 * DM * 2; u.aux = 0; return true; }
        case K_YF: { if (L >= 512) return false; tile_order(L, 64, 8, u.pm, u.pn);
            u.a = (const char*)(ws + WS_YF) + (size_t)u.pm * 256 * 1024 * 2; u.b = (const char*)(ws + WS_WTF) + (size_t)u.pn * 256 * 1024 * 2; u.aux = 0; return true; }
        case K_OUT: { if (L >= 512) return false; tile_order(L, 64, 8, u.pm, u.pn);
            u.a = (const char*)(ws + WS_MIXED) + (size_t)u.pm * 256 * DM * 2; u.b = (const char*)(ws + WS_WTO) + (size_t)u.pn * 256 * DM * 2; u.aux = 0; return true; }
        case K_SC: { if (L >= 512) return false; tile_order(L, 64, 8, u.pm, u.pn);
            u.a = (const char*)(ws + WS_HG) + (size_t)u.pm * 256 * DM * 2; u.b = (const char*)(ws + WS_WTS) + (size_t)u.pn * 256 * DM * 2; u.aux = 0; return true; }
        case K_STEPA: { if (L >= 256) return false; const int bg = L >> 5, q = L & 31, b = bg >> 2, gr = bg & 3; u.pm = bg; u.pn = 0; u.aux = q;
            u.a = (const char*)(ws + WS_ZF) + ((size_t)(b * SEQ + 2 * q) * 1024 + gr * 256) * 2; u.b = (const char*)(ws + WS_TT); return true; }
        case K_STAGE1: { if (L >= 258) return false; u.pm = L; u.pn = 0; u.aux = 0;
            u.a = (const char*)(ws + WS_A1) + (size_t)L * 256 * 512; u.b = (const char*)(ws + WS_F1); return true; }
        case K_STAGE2: { if (L >= 516) return false; u.pm = L; u.pn = 0; u.aux = 0;
            u.a = (const char*)(ws + WS_A2) + (size_t)L * 256 * 256; u.b = (const char*)(ws + WS_F2); return true; }
        }
        return false;
    }
};
__host__ __device__ constexpr g8::Geo geo_of(int kind) {
    switch (kind) {
    case K_INPROJ: case K_YA: case K_OUT: case K_SC: return g8::Geo{2048, 4096u, 128u * 4096u, 4096u, 128u * 4096u};
    case K_GATE8: return g8::Geo{1024, 2048u, 128u * 2048u, 2048u, 128u * 2048u};
    case K_FOLD: return g8::Geo{256, 512u, 128u * 512u, 4096u, 128u * 4096u};
    case K_YF: return g8::Geo{1024, 2048u, 128u * 2048u, 2048u, 128u * 2048u};
    case K_STEPA: return g8::Geo{256, 64u * 2048u, 2048u, 512u, 128u * 512u};
    case K_STAGE1: return g8::Geo{256, 512u, 128u * 512u, 512u, 128u * 512u};
    default: return g8::Geo{128, 256u, 128u * 256u, 256u, 128u * 256u};
    }
}

__device__ __forceinline__ void st8_bf16(bf16_t* p, f32x4 v0, f32x4 v1) {
    u32x4 w; w.x = cvt_pk_bf16(v0[0], v0[1]); w.y = cvt_pk_bf16(v0[2], v0[3]); w.z = cvt_pk_bf16(v1[0], v1[1]); w.w = cvt_pk_bf16(v1[2], v1[3]);
    *(u32x4*)p = w;
}
__device__ __forceinline__ void ld8_bf16(const bf16_t* p, f32x4& v0, f32x4& v1) {
    const u32x4 w = *(const u32x4*)p;
    v0 = (f32x4){bf_lo(w.x), bf_hi(w.x), bf_lo(w.y), bf_hi(w.y)}; v1 = (f32x4){bf_lo(w.z), bf_hi(w.z), bf_lo(w.w), bf_hi(w.w)};
}
__device__ __forceinline__ float sigmoidf_(float x) { return 1.0f / (1.0f + __expf(-x)); }

__device__ __forceinline__ int fp8_exp(float maxg, float extra) { return (int)floorf(__log2f(440.0f / (11.32f * fmaxf(maxg, 1e-6f) * extra))); }
__device__ __forceinline__ int xn8_exp(float maxg1) { return (int)floorf(__log2f(440.0f / (45.26f * fmaxf(maxg1, 1e-6f)))); }
__device__ __forceinline__ int wg8_exp(unsigned gmax_bits) { return (int)floorf(__log2f(440.0f / fmaxf(__uint_as_float(gmax_bits), 1e-30f))); }
template <int kind> struct EpiRM {
    static constexpr bool PERM = true, SWAP = true, FP8 = (kind == K_GATE8);
    Ptrs P; float fsc;
    __device__ __forceinline__ void operator()(f32x4 (&acc)[2][2][4][2], const g8::Unit& u, int wr, int wc, int fr_, int fq_, LAS unsigned char* elds) const {
        unsigned char* ws = P.ws;
        int fr = (kind == K_GATE8) ? (lane_id() & 15) : fr_, fq = (kind == K_GATE8) ? (lane_id() >> 4) : fq_; asm volatile("" : "+v"(fr), "+v"(fq));
        const int row0 = u.pm * 256 + wr * 64 + fr;
        const int ct = wc * 32 + 8 * fq;
        if (kind == K_GATE8) {
            const int pn = u.pn;
            unsigned char* O = ws + (pn < 8 ? WS_GF : WS_GA); const int cbase = (pn & 7) * 256;
#pragma unroll
            for (int ai = 0; ai < 2; ++ai)
#pragma unroll
                for (int m = 0; m < 4; ++m)
#pragma unroll
                    for (int bj = 0; bj < 2; ++bj) {
                        const f32x4 a = acc[ai][bj][m][0], b = acc[ai][bj][m][1]; unsigned w0 = 0u, w1 = 0u;
#pragma unroll
                        for (int x = 0; x < 4; ++x) { w0 = __builtin_amdgcn_cvt_pk_u8_f32(sigmoidf_(a[x] * fsc) * 255.0f, x, w0); w1 = __builtin_amdgcn_cvt_pk_u8_f32(sigmoidf_(b[x] * fsc) * 255.0f, x, w1); }
                        *(u32x2*)(O + (size_t)(row0 + ai * 128 + m * 16) * DM + cbase + ct + bj * 128) = (u32x2){w0, w1};
                    }
        } else if (kind == K_INPROJ) {
            const int pn = u.pn;
            if (pn < 4) {
                bf16_t* O = (bf16_t*)(ws + WS_ZF);
#pragma unroll
                for (int ai = 0; ai < 2; ++ai)
#pragma unroll
                    for (int m = 0; m < 4; ++m)
#pragma unroll
                        for (int bj = 0; bj < 2; ++bj) st8_bf16(O + (size_t)(row0 + ai * 128 + m * 16) * 1024 + pn * 256 + ct + bj * 128, acc[ai][bj][m][0], acc[ai][bj][m][1]);
            } else if (pn < 20) {
                const bool isq = pn < 12;
                LAS float* Pl = (LAS float*)elds;
#pragma unroll
                for (int ai = 0; ai < 2; ++ai)
#pragma unroll
                    for (int m = 0; m < 4; ++m)
#pragma unroll
                        for (int bj = 0; bj < 2; ++bj) {
                            const f32x4 a = acc[ai][bj][m][0], b = acc[ai][bj][m][1];
                            float s = (a[0] * a[0] + a[1] * a[1]) + (a[2] * a[2] + a[3] * a[3]) + (b[0] * b[0] + b[1] * b[1]) + (b[2] * b[2] + b[3] * b[3]);
                            s += __shfl_xor(s, 16); s += __shfl_xor(s, 32);
                            if (fq == 0) Pl[((ai * 128 + wr * 64 + m * 16 + fr) * 2 + bj) * 4 + wc] = s;
                        }
                LDS_WAIT(); __builtin_amdgcn_s_barrier(); asm volatile("" ::: "memory");
                const float* gsrc = isq ? inptr(5) : inptr(6);
                const float extra0 = isq ? (0.08838834764831845f * LOG2E) : 1.0f;
                float extra;
                { const int l_ = lane_id(); const float mg = wave_max(fmaxf(fabsf(gsrc[l_]), fabsf(gsrc[l_ + 64]))); extra = extra0 * exp2f((float)fp8_exp(mg, extra0)); }
                const f32x4 g0 = *(const f32x4*)(gsrc + ct) * extra, g1 = *(const f32x4*)(gsrc + ct + 4) * extra;
                unsigned char* O = ws + (isq ? WS_Q8 : WS_K);
                const int cbase = (isq ? (pn - 4) : (pn - 12)) * 256;
#pragma unroll
                for (int ai = 0; ai < 2; ++ai)
#pragma unroll
                    for (int m = 0; m < 4; ++m)
#pragma unroll
                        for (int bj = 0; bj < 2; ++bj) {
                            const f32x4 t = *(const LAS f32x4*)(Pl + ((ai * 128 + wr * 64 + m * 16 + fr) * 2 + bj) * 4);
                            const float rinv = 1.0f / sqrtf(((t[0] + t[1]) + (t[2] + t[3])) * (1.0f / 128.0f) + EPS);
                            const int rw = row0 + ai * 128 + m * 16;
                            unsigned char* dst = isq ? O + (size_t)rw * DM + cbase + ct + bj * 128
                                                     : O + ((size_t)(((rw >> 13) * 16 + (pn - 12) * 2 + bj) * SEQ + (rw & (SEQ - 1)))) * 128 + ct;
                            { const f32x4 v0 = acc[ai][bj][m][0] * rinv * g0, v1 = acc[ai][bj][m][1] * rinv * g1;
                              int w0 = __builtin_amdgcn_cvt_pk_fp8_f32(v0[0], v0[1], 0, false); w0 = __builtin_amdgcn_cvt_pk_fp8_f32(v0[2], v0[3], w0, true);
                              int w1 = __builtin_amdgcn_cvt_pk_fp8_f32(v1[0], v1[1], 0, false); w1 = __builtin_amdgcn_cvt_pk_fp8_f32(v1[2], v1[3], w1, true);
                              *(u32x2*)dst = (u32x2){(unsigned)w0, (unsigned)w1}; }
                        }
                LDS_WAIT(); __builtin_amdgcn_s_barrier(); asm volatile("" ::: "memory");
            } else if (pn < 28) {
                bf16_t* O = (bf16_t*)(ws + WS_V);
#pragma unroll
                for (int ai = 0; ai < 2; ++ai)
#pragma unroll
                    for (int m = 0; m < 4; ++m)
#pragma unroll
                        for (int bj = 0; bj < 2; ++bj) { const int rw = row0 + ai * 128 + m * 16;
                            st8_bf16(O + ((size_t)(((rw >> 13) * 16 + (pn - 20) * 2 + bj) * SEQ + (rw & (SEQ - 1)))) * 128 + ct, acc[ai][bj][m][0], acc[ai][bj][m][1]); }
            }
        } else if (kind == K_FOLD) {
            bf16_t* O = (bf16_t*)(ws + WS_WTS);
#pragma unroll
            for (int ai = 0; ai < 2; ++ai)
#pragma unroll
                for (int m = 0; m < 4; ++m)
#pragma unroll
                    for (int bj = 0; bj < 2; ++bj) st8_bf16(O + (size_t)(row0 + ai * 128 + m * 16) * DM + u.pn * 256 + ct + bj * 128, acc[ai][bj][m][0], acc[ai][bj][m][1]);
        } else if (kind == K_YA || kind == K_YF) {
            bf16_t* O = (bf16_t*)(ws + WS_MIXED); const unsigned char* Gt = ws + (kind == K_YA ? WS_GA : WS_GF);
#pragma unroll
            for (int ai = 0; ai < 2; ++ai) {
                u32x2 gw_[8]; u32x4 pw_[8];
#pragma unroll
                for (int m = 0; m < 4; ++m)
#pragma unroll
                    for (int bj = 0; bj < 2; ++bj) { const size_t off = (size_t)(row0 + ai * 128 + m * 16) * DM + u.pn * 256 + ct + bj * 128;
                        gw_[m * 2 + bj] = *(const u32x2*)(Gt + off); if (kind == K_YF) pw_[m * 2 + bj] = *(const u32x4*)(O + off); }
#pragma unroll
                for (int m = 0; m < 4; ++m)
#pragma unroll
                    for (int bj = 0; bj < 2; ++bj) {
                        const size_t off = (size_t)(row0 + ai * 128 + m * 16) * DM + u.pn * 256 + ct + bj * 128;
                        const u32x2 w = gw_[m * 2 + bj]; constexpr float k255 = 1.0f / 255.0f;
                        const f32x4 g0 = (f32x4){(float)(w.x & 0xFFu), (float)((w.x >> 8) & 0xFFu), (float)((w.x >> 16) & 0xFFu), (float)(w.x >> 24)} * k255,
                                    g1 = (f32x4){(float)(w.y & 0xFFu), (float)((w.y >> 8) & 0xFFu), (float)((w.y >> 16) & 0xFFu), (float)(w.y >> 24)} * k255;
                        f32x4 a = acc[ai][bj][m][0] * g0, b = acc[ai][bj][m][1] * g1;
                        if (kind == K_YF) { const u32x4 q = pw_[m * 2 + bj]; a += (f32x4){bf_lo(q.x), bf_hi(q.x), bf_lo(q.y), bf_hi(q.y)}; b += (f32x4){bf_lo(q.z), bf_hi(q.z), bf_lo(q.w), bf_hi(q.w)}; }
                        st8_bf16(O + off, a, b);
                    }
            }
        } else if (kind == K_OUT) {
            const float* X = inptr(0); float* H = P.out; bf16_t* HG = (bf16_t*)(ws + WS_HG); const float* g2 = inptr(13);
#pragma unroll
            for (int bj = 0; bj < 2; ++bj) {
                const int col = u.pn * 256 + ct + bj * 128;
                const f32x4 ga = *(const f32x4*)(g2 + col), gb = *(const f32x4*)(g2 + col + 4);
                f32x4 xv[8][2];
#pragma unroll
                for (int ai = 0; ai < 2; ++ai)
#pragma unroll
                    for (int m = 0; m < 4; ++m) { const size_t off = (size_t)(row0 + ai * 128 + m * 16) * DM + col; xv[ai * 4 + m][0] = *(const f32x4*)(X + off); xv[ai * 4 + m][1] = *(const f32x4*)(X + off + 4); }
#pragma unroll
                for (int ai = 0; ai < 2; ++ai)
#pragma unroll
                    for (int m = 0; m < 4; ++m) {
                        const size_t off = (size_t)(row0 + ai * 128 + m * 16) * DM + col;
                        const f32x4 h0 = xv[ai * 4 + m][0] + acc[ai][bj][m][0], h1 = xv[ai * 4 + m][1] + acc[ai][bj][m][1];
                        *(f32x4*)(H + off) = h0; *(f32x4*)(H + off + 4) = h1;
                        st8_bf16(HG + off, h0 * ga, h1 * gb);
                    }
            }
        } else {
            float* SC = (float*)(ws + WS_SC);
#pragma unroll
            for (int ai = 0; ai < 2; ++ai)
#pragma unroll
                for (int m = 0; m < 4; ++m)
#pragma unroll
                    for (int bj = 0; bj < 2; ++bj) {
                        const size_t off = (size_t)(row0 + ai * 128 + m * 16) * DM + u.pn * 256 + ct + bj * 128;
                        *(f32x4*)(SC + off) = acc[ai][bj][m][0]; *(f32x4*)(SC + off + 4) = acc[ai][bj][m][1];
                    }
        }
    }
};

template <int kind> struct EpiT {
    static constexpr bool PERM = false, SWAP = false, FP8 = false;
    Ptrs P; float fsc;
    __device__ __forceinline__ void operator()(f32x4 (&acc)[2][2][4][2], const g8::Unit& u, int wr, int wc, int fr_, int fq_, LAS unsigned char* elds) const {
        unsigned char* ws = P.ws;
        int fr = fr_, fq = fq_; asm volatile("" : "+v"(fr), "+v"(fq));
        if (kind == K_STEPA) {
            bf16_t* A1 = (bf16_t*)(ws + WS_A1); const int bg = u.pm, q = u.aux;
#pragma unroll
            for (int ai = 0; ai < 2; ++ai)
#pragma unroll
                for (int bj = 0; bj < 2; ++bj)
#pragma unroll
                    for (int m = 0; m < 4; ++m)
#pragma unroll
                        for (int n = 0; n < 2; ++n) {
                            const int n1 = wr * 64 + m * 16 + 4 * fq, n2 = 2 * q + ai, jp = bj * 128 + wc * 32 + n * 16 + fr;
                            const int kc = jp <= 128 ? jp : jp - 128, ri = jp <= 128 ? 0 : 1;
                            const f32x4 v = acc[ai][bj][m][n];
                            u32x2 w; w.x = cvt_pk_bf16(v[0], v[1]); w.y = cvt_pk_bf16(v[2], v[3]);
                            *(u32x2*)(A1 + ((size_t)((bg * NKC + kc) * 64 + n2) * 2 + ri) * 128 + n1) = w;
                            if (jp == 0 || jp == 128) *(u32x2*)(A1 + ((size_t)((bg * NKC + kc) * 64 + n2) * 2 + 1) * 128 + n1) = (u32x2){0u, 0u};
                            __builtin_amdgcn_sched_barrier(0);
                        }
        } else if (kind == K_STAGE1) {
            bf16_t* A2 = (bf16_t*)(ws + WS_A2);
#pragma unroll
            for (int ai = 0; ai < 2; ++ai)
#pragma unroll
                for (int m = 0; m < 4; ++m) {
                    const int Rg = u.pm * 256 + ai * 128 + wr * 64 + m * 16 + 4 * fq, bgkc = Rg >> 6, n2 = Rg & 63, bg = bgkc / NKC, kc = bgkc - bg * NKC;
#pragma unroll
                    for (int n = 0; n < 2; ++n) {
                        const int k1 = wc * 32 + n * 16 + fr;
                        const f32x4 re = acc[ai][0][m][n], im = acc[ai][1][m][n]; f32x4 orr, oi;
#pragma unroll
                        for (int x = 0; x < 4; ++x) {
                            const float ph = (float)(((n2 + x) * k1) & 8191) * (1.0f / 8192.0f);
                            const float c = __builtin_amdgcn_cosf(ph), s = __builtin_amdgcn_sinf(ph);
                            orr[x] = re[x] * c + im[x] * s; oi[x] = im[x] * c - re[x] * s;
                        }
                        bf16_t* dst = A2 + ((size_t)((bg * 128 + k1) * NKC + kc) * 2) * 64 + n2;
                        u32x2 w0, w1; w0.x = cvt_pk_bf16(orr[0], orr[1]); w0.y = cvt_pk_bf16(orr[2], orr[3]); w1.x = cvt_pk_bf16(oi[0], oi[1]); w1.y = cvt_pk_bf16(oi[2], oi[3]);
                        *(u32x2*)dst = w0; *(u32x2*)(dst + 64) = w1;
                        __builtin_amdgcn_sched_barrier(0);
                    }
                }
        } else {
            LAS unsigned char* T = elds; bf16_t* YF = (bf16_t*)(ws + WS_YF);
            const int lane = fr + 16 * fq, W = wr * 4 + wc;
#pragma unroll
            for (int ai = 0; ai < 2; ++ai) {
                if (wc < 2) {
#pragma unroll
                    for (int m = 0; m < 4; ++m)
#pragma unroll
                        for (int n = 0; n < 2; ++n) { const int k2 = wc * 32 + n * 16 + fr; const f32x4 v = acc[ai][0][m][n];
                            u32x2 w; w.x = cvt_pk_bf16(v[0], v[1]); w.y = cvt_pk_bf16(v[2], v[3]);
                            *(LAS u32x2*)(T + k2 * 264 + (wr * 64 + m * 16 + 4 * fq) * 2) = w; }
                }
                LDS_WAIT(); __builtin_amdgcn_s_barrier(); asm volatile("" ::: "memory");
#pragma unroll
                for (int p2 = 0; p2 < 2; ++p2) {
                    const int rl = 64 * p2 + lane, Rg = u.pm * 256 + ai * 128 + rl, bg = Rg / (128 * NKC), rem = Rg - bg * (128 * NKC), k1 = rem / NKC, kc = rem - k1 * NKC;
                    const int b = bg >> 2, gr = bg & 3; const bool s1 = kc <= 128, s2 = kc >= 1 && kc <= 127;
#pragma unroll
                    for (int j = 0; j < 8; ++j) { const int k2 = 8 * W + j, k = k1 + 128 * k2;
                        const bf16_t o = *(const LAS bf16_t*)(T + k2 * 264 + rl * 2);
                        if (s1) YF[(size_t)(b * SEQ + k) * 1024 + gr * 256 + kc] = o;
                        if (s2) YF[(size_t)(b * SEQ + ((SEQ - k) & (SEQ - 1))) * 1024 + gr * 256 + 256 - kc] = o; }
                }
                LDS_WAIT(); __builtin_amdgcn_s_barrier(); asm volatile("" ::: "memory");
            }
        }
    }
};

namespace att {
constexpr int KSLOT = 16384, VSLOT = 32768, NSLOT = 3, NVSLOT = 3;
constexpr int NQR = 8;
constexpr int L_K = 0, L_V = NSLOT * KSLOT, L_Q = L_V + NVSLOT * VSLOT, QPAGE = (8 - NQR) * 1024, L_WS = L_Q + 8 * QPAGE;
__device__ __forceinline__ int crow(int r, int hi) { return (r & 3) + 8 * (r >> 2) + 4 * hi; }
#define SBAR() __builtin_amdgcn_sched_barrier(0)
__device__ __forceinline__ void glds16(const void* gbase, unsigned voff, unsigned lds_dst) { unsigned keep;
    asm volatile("s_mov_b32 %0, m0\n\ts_mov_b32 m0, %3\n\ts_nop 0\n\tglobal_load_lds_dwordx4 %1, %2\n\ts_mov_b32 m0, %0" : "=&s"(keep) : "v"(voff), "s"(gbase), "s"(lds_dst) : "memory"); }
template <int OFF> __device__ __forceinline__ s16x4 tr_read(int vb) {
    s16x4 r; asm volatile("ds_read_b64_tr_b16 %0, %1 offset:%2" : "=&v"(r) : "v"(vb), "i"(OFF) : "memory"); return r;
}
template <int D0, int KH> __device__ __forceinline__ void pvh_pair(f32x16& oa, f32x16& ob, int vb, bf16x8 pa, bf16x8 pb) {
    const s16x4 al0 = tr_read<D0 * 512 + (2 * KH) * 8192>(vb), ah0 = tr_read<D0 * 512 + (2 * KH) * 8192 + 4096>(vb), bl0 = tr_read<(D0 + 1) * 512 + (2 * KH) * 8192>(vb), bh0 = tr_read<(D0 + 1) * 512 + (2 * KH) * 8192 + 4096>(vb);
    const s16x4 al1 = tr_read<D0 * 512 + (2 * KH + 1) * 8192>(vb), ah1 = tr_read<D0 * 512 + (2 * KH + 1) * 8192 + 4096>(vb), bl1 = tr_read<(D0 + 1) * 512 + (2 * KH + 1) * 8192>(vb), bh1 = tr_read<(D0 + 1) * 512 + (2 * KH + 1) * 8192 + 4096>(vb);
    asm volatile("s_waitcnt lgkmcnt(0)" ::: "memory"); SBAR();
#define PKV(L, H) (bf16x8){L[0], L[1], L[2], L[3], H[0], H[1], H[2], H[3]}
    oa = __builtin_amdgcn_mfma_f32_32x32x16_bf16(pa, PKV(al0, ah0), oa, 0, 0, 0); ob = __builtin_amdgcn_mfma_f32_32x32x16_bf16(pa, PKV(bl0, bh0), ob, 0, 0, 0);
    oa = __builtin_amdgcn_mfma_f32_32x32x16_bf16(pb, PKV(al1, ah1), oa, 0, 0, 0); ob = __builtin_amdgcn_mfma_f32_32x32x16_bf16(pb, PKV(bl1, bh1), ob, 0, 0, 0);
#undef PKV
}
#define PV_RD(D0, KH, R) do { \
    R[0] = tr_read<(D0) * 512 + (2 * (KH)) * 8192>(vb); R[1] = tr_read<(D0) * 512 + (2 * (KH)) * 8192 + 4096>(vb); R[2] = tr_read<((D0) + 1) * 512 + (2 * (KH)) * 8192>(vb); R[3] = tr_read<((D0) + 1) * 512 + (2 * (KH)) * 8192 + 4096>(vb); \
    R[4] = tr_read<(D0) * 512 + (2 * (KH) + 1) * 8192>(vb); R[5] = tr_read<(D0) * 512 + (2 * (KH) + 1) * 8192 + 4096>(vb); R[6] = tr_read<((D0) + 1) * 512 + (2 * (KH) + 1) * 8192>(vb); R[7] = tr_read<((D0) + 1) * 512 + (2 * (KH) + 1) * 8192 + 4096>(vb); } while (0)
#define PV_MM(oa, ob, R) do { \
    oa = __builtin_amdgcn_mfma_f32_32x32x16_bf16(pa, (bf16x8){R[0][0], R[0][1], R[0][2], R[0][3], R[1][0], R[1][1], R[1][2], R[1][3]}, oa, 0, 0, 0); ob = __builtin_amdgcn_mfma_f32_32x32x16_bf16(pa, (bf16x8){R[2][0], R[2][1], R[2][2], R[2][3], R[3][0], R[3][1], R[3][2], R[3][3]}, ob, 0, 0, 0); \
    oa = __builtin_amdgcn_mfma_f32_32x32x16_bf16(pb, (bf16x8){R[4][0], R[4][1], R[4][2], R[4][3], R[5][0], R[5][1], R[5][2], R[5][3]}, oa, 0, 0, 0); ob = __builtin_amdgcn_mfma_f32_32x32x16_bf16(pb, (bf16x8){R[6][0], R[6][1], R[6][2], R[6][3], R[7][0], R[7][1], R[7][2], R[7][3]}, ob, 0, 0, 0); } while (0)
template <int KH> __device__ __forceinline__ void pv_half(f32x16 (&o)[8], int vb, bf16x8 pa, bf16x8 pb) {
    s16x4 ra[8], rb[8];
    PV_RD(0, KH, ra); PV_RD(2, KH, rb);
    asm volatile("s_waitcnt lgkmcnt(8)" ::: "memory"); SBAR(); PV_MM(o[0], o[1], ra); SBAR();
    PV_RD(4, KH, ra);
    asm volatile("s_waitcnt lgkmcnt(8)" ::: "memory"); SBAR(); PV_MM(o[2], o[3], rb); SBAR();
    PV_RD(6, KH, rb);
    asm volatile("s_waitcnt lgkmcnt(8)" ::: "memory"); SBAR(); PV_MM(o[4], o[5], ra); SBAR();
    asm volatile("s_waitcnt lgkmcnt(0)" ::: "memory"); SBAR(); PV_MM(o[6], o[7], rb);
}
#define KSWZ(row, colB) ((row) * 256 + ((colB) ^ (((row) & 15) << 4)))
#define PK4(Pv, BASE, OUT) do { unsigned a0 = cvt_pk_bf16(Pv[BASE + 0], Pv[BASE + 1]), a1 = cvt_pk_bf16(Pv[BASE + 2], Pv[BASE + 3]);   \
    unsigned b0_ = cvt_pk_bf16(Pv[BASE + 4], Pv[BASE + 5]), b1_ = cvt_pk_bf16(Pv[BASE + 6], Pv[BASE + 7]);                              \
    auto r0 = __builtin_amdgcn_permlane32_swap(a0, b0_, false, false); auto r1 = __builtin_amdgcn_permlane32_swap(a1, b1_, false, false); \
    u32x4 w = {r0[0], r1[0], r0[1], r1[1]}; OUT = __builtin_bit_cast(bf16x8, w); } while (0)

template <int KH> __device__ __forceinline__ void half_tile(f32x16 (&o)[8], float& lsum, const i32x8 (&q8)[2], int sclK, int sclQ, const LAS unsigned char* Ks, int vb, float dq, float nslope2, float negM2, int side, int r32, int hi) {
    f32x16 p;
    if (side != 0) {
        const float bsl = side > 0 ? -nslope2 : nslope2, a0 = __builtin_fmaf(-bsl, dq, negM2);
#pragma unroll
        for (int r = 0; r < 16; ++r) asm("v_fmamk_f32 %0, %1, %3, %2" : "=v"(p[r]) : "v"(bsl), "v"(a0), "i"(__builtin_bit_cast(int, (float)((r & 3) + 8 * (r >> 2) + 32 * KH))));
    } else {
#pragma unroll
        for (int r = 0; r < 16; ++r) { const float cr = (float)((r & 3) + 8 * (r >> 2) + 32 * KH); const float t0 = dq - cr;
            asm("v_fma_f32 %0, |%1|, %2, %3" : "=v"(p[r]) : "v"(t0), "s"(nslope2), "v"(negM2)); }
    }
    { const int sw = (r32 >> 1) & 7; const LAS unsigned char* kr = Ks + (32 * KH + r32) * 128;
      u32x4 kc[4];
#pragma unroll
      for (int m = 0; m < 2; ++m) { kc[2 * m] = *(const LAS u32x4*)(kr + (((4 * m + hi) ^ sw) * 16)); kc[2 * m + 1] = *(const LAS u32x4*)(kr + (((4 * m + 2 + hi) ^ sw) * 16)); }
#pragma unroll
      for (int m = 0; m < 2; ++m) { const i32x8 kf = {(int)kc[2 * m][0], (int)kc[2 * m][1], (int)kc[2 * m][2], (int)kc[2 * m][3], (int)kc[2 * m + 1][0], (int)kc[2 * m + 1][1], (int)kc[2 * m + 1][2], (int)kc[2 * m + 1][3]};
          p = __builtin_amdgcn_mfma_scale_f32_32x32x64_f8f6f4(kf, q8[m], p, 0, 0, 0, sclK, 0, sclQ); } }
    float ps = 0.f;
#pragma unroll
    for (int r = 0; r < 16; ++r) { p[r] = __builtin_amdgcn_exp2f(p[r]); ps += p[r]; }
    lsum += ps;
    bf16x8 pa, pb;
    PK4(p, 0, pa); PK4(p, 8, pb);
    pv_half<KH>(o, vb, pa, pb);
}

__device__ __forceinline__ void attn_pass(f32x16 (&o)[8], int b, int h, int c, int qb, int t_lo, int NT, float nslope2, float negM2,
                                          const unsigned char* __restrict__ Q, const unsigned char* __restrict__ K, const bf16_t* __restrict__ V, LAS unsigned char* lds, int wid0, int sclK, int sclQ) {
    int tid_ = wid0 * 64 + lane_id(); asm volatile("" : "+v"(tid_));
    const int tid = tid_, lane = tid & 63, r32 = lane & 31, hi = lane >> 5; const int wid = __builtin_amdgcn_readfirstlane(tid >> 6);
    const size_t rowbase = (size_t)b * SEQ;
    i32x8 q8[2];
    { const unsigned char* Qw = Q + (rowbase + qb * 256 + wid * 32 + r32) * DM + h * 256 + c * 128 + hi * 16;
#pragma unroll
      for (int m = 0; m < 2; ++m) { const u32x4 c0 = *(const u32x4*)(Qw + 64 * m), c1 = *(const u32x4*)(Qw + 64 * m + 32);
          q8[m] = (i32x8){(int)c0[0], (int)c0[1], (int)c0[2], (int)c0[3], (int)c1[0], (int)c1[1], (int)c1[2], (int)c1[3]}; }
      asm volatile("" :: "v"(q8[0]), "v"(q8[1]));
    }
    const unsigned char* Kh = K + (size_t)((b * 16 + h * 2 + c) * SEQ) * 128; const bf16_t* Vh = V + (size_t)((b * 16 + h * 2) * SEQ) * 128;
    unsigned kofs, vofs[4];
    { const int row_ = 8 * wid + (lane >> 3); kofs = (unsigned)(row_ * 128 + (((lane & 7) ^ ((row_ >> 1) & 7)) * 16)); }
#pragma unroll
    for (int i = 0; i < 4; ++i) { const int p_ = 4 * wid + i, kg_ = p_ >> 2, cb_ = 2 * (p_ & 3) + (lane >> 5), kk_ = kg_ * 8 + ((lane >> 2) & 7), key_ = (kk_ & ~0xC) | ((kk_ & 4) << 1) | ((kk_ & 8) >> 1);
        const int col_ = cb_ * 32 + (lane & 3) * 8; vofs[i] = (unsigned)((col_ >> 7) * (SEQ * 128 * 2) + key_ * 256 + (col_ & 127) * 2); }
    const unsigned lds0 = (unsigned)(uintptr_t)lds;
#define DMA_K(t) do { const unsigned char* kb_ = Kh + (size_t)(t_lo + (t)) * 64 * 128; const int sl_ = (t) % NSLOT; \
        glds16(kb_, kofs, (unsigned)__builtin_amdgcn_readfirstlane((int)(lds0 + L_K + sl_ * KSLOT + wid * 1024))); } while (0)
#define DMA_V(t) do { const bf16_t* vb_ = Vh + (size_t)(t_lo + (t)) * 64 * 128; const int sl_ = (t) % NVSLOT; \
        _Pragma("unroll") for (int _i = 0; _i < 4; ++_i) glds16(vb_, vofs[_i], (unsigned)__builtin_amdgcn_readfirstlane((int)(lds0 + L_V + sl_ * VSLOT + (4 * wid + _i) * 1024))); } while (0)
    const int vrd = ((lane & 3) << 3) | (((lane >> 2) & 3) << 6) | (((lane >> 4) & 1) << 5) | (((lane >> 5) & 1) << 8);
    const int vb0 = (int)(unsigned)(uintptr_t)(lds + L_V) + vrd;
#pragma unroll
    for (int d = 0; d < 8; ++d) o[d] = f32x16{};
    float lsum = 0.f;
    const int qw0 = qb * 256 + wid * 32;
    const int qpos = qw0 + r32 - 4 * hi;
    DMA_K(0); DMA_V(0); if (NT > 1) { DMA_K(1); DMA_V(1); }
    for (int j = 0; j < NT; ++j) {
        if (j + 1 < NT) asm volatile("s_waitcnt vmcnt(5)" ::: "memory"); else asm volatile("s_waitcnt vmcnt(0)" ::: "memory");
        __builtin_amdgcn_s_barrier(); asm volatile("" ::: "memory");
        const LAS unsigned char* Ks = lds + L_K + (j % NSLOT) * KSLOT; const int vb = vb0 + (j % NVSLOT) * VSLOT;
        const int kt0 = (t_lo + j) * 64, side = (kt0 + 63 < qw0) ? 1 : ((kt0 > qw0 + 31) ? -1 : 0);
        const float dq = (float)(qpos - kt0);
        half_tile<0>(o, lsum, q8, sclK, sclQ, Ks, vb, dq, nslope2, negM2, side, r32, hi);
        if (j + 2 < NT) { DMA_K(j + 2); DMA_V(j + 2); }
        half_tile<1>(o, lsum, q8, sclK, sclQ, Ks, vb, dq, nslope2, negM2, side, r32, hi);
    }
    LDS_WAIT(); __builtin_amdgcn_s_barrier(); asm volatile("" ::: "memory");
    { auto rr = __builtin_amdgcn_permlane32_swap(__float_as_uint(lsum), __float_as_uint(lsum), false, false); lsum = __uint_as_float(rr[0]) + __uint_as_float(rr[1]); }
    LAS float* wsf = (LAS float*)(lds + L_WS) + wid * 64;
    if (hi == 0) wsf[r32] = lsum; LDS_WAIT();
#pragma unroll
    for (int r = 0; r < 16; ++r) { const float rl = __builtin_amdgcn_rcpf(wsf[crow(r, hi)]);
#pragma unroll
        for (int d = 0; d < 8; ++d) o[d][r] *= rl; }
    LDS_WAIT();
#undef DMA_K
#undef DMA_V
}

__device__ __forceinline__ void attn_unit(int unit, const Ptrs& P, LAS unsigned char* lds, int lam_bits, int Mb_bits, int scl_bits) {
    int tid_ = P.wid0 * 64 + lane_id(); asm volatile("" : "+v"(tid_));
    const int tid = tid_, lane = tid & 63, r32 = lane & 31, hi = lane >> 5; const int wid = __builtin_amdgcn_readfirstlane(tid >> 6);
    const int qq = unit >> 6, uu = unit & 63;
    int b, hidx;
    if (qq < 6) { if ((uu >> 5) == 0) { b = qq & 1; hidx = 7 - (qq >> 1); } else { const int k2 = qq >> 1; hidx = 2 - k2; b = qq & 1; } }
    else { b = qq & 1; hidx = (uu >> 5) ? 3 : 4; }
    const int ii = uu & 31, qb = (ii & 1) ? 16 + (ii >> 1) : 15 - (ii >> 1);
    lam_bits = __builtin_amdgcn_readfirstlane(lam_bits); Mb_bits = __builtin_amdgcn_readfirstlane(Mb_bits);
    asm volatile("" : "+s"(lam_bits), "+s"(Mb_bits));
    const float lam = __int_as_float(lam_bits), Mb = __int_as_float(Mb_bits);
    const float slope = exp2f(-(float)(hidx + 1));
    int w = (int)ceilf((2.f * Mb + 104.f) / slope); if (w > SEQ) w = SEQ;
    const int klo = (qb * 256 - w) < 0 ? 0 : (qb * 256 - w), khi = (qb * 256 + 255 + w) > (SEQ - 1) ? (SEQ - 1) : (qb * 256 + 255 + w);
    const int t_lo = klo >> 6, NT = (khi >> 6) - t_lo + 1;
    const unsigned char* Q = P.ws + WS_Q8; const unsigned char* K = P.ws + WS_K; const bf16_t* V = (const bf16_t*)(P.ws + WS_V);
    const int sclQ = (scl_bits & 0xFF) * 0x01010101, sclK = ((scl_bits >> 8) & 0xFF) * 0x01010101;
    unsigned char* stash_b = (unsigned char*)P.out + (size_t)blockIdx.x * (32 * 8192);
#define STASH(i) ((f32x4*)(stash_b + (size_t)(i) * 8192 + st_))
    f32x16 o[8];
    attn_pass(o, b, hidx, 0, qb, t_lo, NT, -slope * LOG2E, -Mb * LOG2E, Q, K, V, lds, P.wid0, sclK, sclQ);
    { unsigned st_ = 16u * (unsigned)(P.wid0 * 64 + lane_id()); asm volatile("" : "+v"(st_));
#pragma unroll
      for (int d = 0; d < 8; ++d) {
#pragma unroll
          for (int r4 = 0; r4 < 4; ++r4) *STASH(d * 4 + r4) = (f32x4){o[d][r4 * 4], o[d][r4 * 4 + 1], o[d][r4 * 4 + 2], o[d][r4 * 4 + 3]};
          asm volatile("" : "+v"(st_)); } }
    attn_pass(o, b, hidx, 1, qb, t_lo, NT, -slope * LOG2E, -Mb * LOG2E, Q, K, V, lds, P.wid0, sclK, sclQ);
    float ss[16];
#pragma unroll
    for (int r = 0; r < 16; ++r) ss[r] = 0.f;
    { unsigned st_ = 16u * (unsigned)(P.wid0 * 64 + lane_id()); asm volatile("" : "+v"(st_));
#pragma unroll
      for (int d = 0; d < 8; ++d) {
#pragma unroll
          for (int r4 = 0; r4 < 4; ++r4) { const f32x4 s1 = *STASH(d * 4 + r4);
#pragma unroll
              for (int i = 0; i < 4; ++i) { const float x = s1[i] - lam * o[d][r4 * 4 + i]; o[d][r4 * 4 + i] = x; ss[r4 * 4 + i] += x * x; } }
          asm volatile("" : "+v"(st_) :: "memory");
      } }
#pragma unroll
    for (int r = 0; r < 16; ++r) {
#pragma unroll
        for (int off = 1; off < 32; off <<= 1) ss[r] += __shfl_xor(ss[r], off);
        ss[r] = (1.0f - LAM_INIT) / sqrtf(ss[r] * (1.0f / 256.0f) + EPS);
    }
    const float* sg = inptr(11);
    LAS bf16_t* stg = (LAS bf16_t*)(lds + wid * 16384);
#pragma unroll
    for (int d = 0; d < 8; ++d) { const float gcol = sg[d * 32 + r32];
#pragma unroll
        for (int r = 0; r < 16; ++r) stg[crow(r, hi) * 256 + d * 32 + r32] = (bf16_t)(cvt_pk_bf16(o[d][r] * ss[r] * gcol, 0.f) & 0xffffu); }
    LDS_WAIT(); asm volatile("" ::: "memory");
    bf16_t* Ow = (bf16_t*)(P.ws + WS_O) + ((size_t)b * SEQ + qb * 256 + wid * 32) * DM + hidx * 256;
#pragma unroll 4
    for (int i = 0; i < 16; ++i) { const int row = 2 * i + (lane >> 5), ch = lane & 31;
        const u32x4 v = *(const LAS u32x4*)(stg + row * 256 + ch * 8); *(u32x4*)(Ow + (size_t)row * DM + ch * 8) = v; }
    LDS_WAIT(); VM_WAIT();
#undef STASH
}
#undef PK4
#undef SBAR
#undef KSWZ
}

__device__ __forceinline__ unsigned f2bf(float f) { return cvt_pk_bf16(f, 0.f) & 0xffffu; }
struct P0Item { const float* W; bf16_t* WT; int K, N, item; };
__device__ __forceinline__ bool p0_item(const Ptrs& P, int it, P0Item& d) {
    constexpr int I_IN = (DM / 64) * (INW / 32), I_F = (1024 / 64) * (DM / 32), I_A = (DM / 64) * (DM / 32), I_O = I_A;
    unsigned char* ws = P.ws; int r = it;
    if (r < I_IN) { d = P0Item{inptr(2), (bf16_t*)(ws + WS_WTIN), DM, INW, r}; return true; } r -= I_IN;
    if (r < I_F) { d = P0Item{inptr(3), (bf16_t*)(ws + WS_WTF), 1024, DM, r}; return true; } r -= I_F;
    if (r < I_A) { d = P0Item{inptr(4), (bf16_t*)(ws + WS_WTA), DM, DM, r}; return true; } r -= I_A;
    if (r < I_O) { d = P0Item{inptr(12), (bf16_t*)(ws + WS_WTO), DM, DM, r}; return true; }
    return false;
}
__device__ __forceinline__ void p0_load(const P0Item& d, float (&v)[32], int lane) {
    const int nblk = d.N / 32, kb = d.item / nblk, nb = d.item % nblk, k0 = 64 * kb, n0 = 32 * nb;
#pragma unroll
    for (int i = 0; i < 32; ++i) { const int kk = 2 * i + (lane >> 5); v[i] = d.W[(size_t)(k0 + kk) * d.N + n0 + (lane & 31)]; }
}
__device__ __forceinline__ float p0_store(const P0Item& d, const float (&v)[32], LAS float* scr, int lane) {
    const int nblk = d.N / 32, kb = d.item / nblk, nb = d.item % nblk, k0 = 64 * kb, n0 = 32 * nb; float am = 0.f;
#pragma unroll
    for (int i = 0; i < 32; ++i) { const int kk = 2 * i + (lane >> 5); am = fmaxf(am, fabsf(v[i])); scr[kk * 33 + (lane & 31)] = v[i]; }
    LDS_WAIT(); asm volatile("" ::: "memory");
    const int c = lane & 7;
#pragma unroll
    for (int j = 0; j < 4; ++j) { const int n = (lane >> 3) + 8 * j; const LAS float* s = scr + (8 * c) * 33 + n;
        u32x4 o; o.x = cvt_pk_bf16(s[0 * 33], s[1 * 33]); o.y = cvt_pk_bf16(s[2 * 33], s[3 * 33]); o.z = cvt_pk_bf16(s[4 * 33], s[5 * 33]); o.w = cvt_pk_bf16(s[6 * 33], s[7 * 33]);
        *(u32x4*)(d.WT + (size_t)(n0 + n) * d.K + k0 + 8 * c) = o; }
    LDS_WAIT(); asm volatile("" ::: "memory");
    return am;
}
__device__ __forceinline__ void p0_prologue(const Ptrs& P, LAS unsigned char* lds) {
    int tid_ = P.wid0 * 64 + lane_id(); asm volatile("" : "+v"(tid_));
    const int tid = tid_, lane = tid & 63, wid = __builtin_amdgcn_readfirstlane(tid >> 6);
    const int gw = blockIdx.x * 8 + wid, NGW = gridDim.x * 8;
    LAS float* scr = (LAS float*)(lds + wid * 16384);
    unsigned char* ws = P.ws;
    { P0Item cur, nxt; float va[32], vb[32];
      bool has = p0_item(P, gw, cur);
      if (has) p0_load(cur, va, lane);
      for (int it = gw; has; it += 2 * NGW) {
          const bool h1 = p0_item(P, it + NGW, nxt);
          if (h1) p0_load(nxt, vb, lane);
          { const float am = p0_store(cur, va, scr, lane);
            if (cur.N == INW && (cur.item % (INW / 32)) * 32 >= 7168) { const float wm = wave_max(am); if (lane == 0) atomicMax((unsigned*)(ws + WS_CTL) + CW_GMAX, __float_as_uint(wm)); } }
          if (!h1) break;
          has = p0_item(P, it + 2 * NGW, cur);
          if (has) p0_load(cur, va, lane);
          { const float am = p0_store(nxt, vb, scr, lane);
            if (nxt.N == INW && (nxt.item % (INW / 32)) * 32 >= 7168) { const float wm = wave_max(am); if (lane == 0) atomicMax((unsigned*)(ws + WS_CTL) + CW_GMAX, __float_as_uint(wm)); } }
      } }
    const int gt = blockIdx.x * 512 + tid, NGT = gridDim.x * 512;
    { const float* wq = inptr(14); bf16_t* o = (bf16_t*)(ws + WS_WQ16);
      for (int i = gt; i < DM * DM / 8; i += NGT) { const f32x4 a = *(const f32x4*)(wq + (size_t)i * 8), b = *(const f32x4*)(wq + (size_t)i * 8 + 4); st8_bf16(o + (size_t)i * 8, a, b); } }
    { const float* sk = inptr(15); bf16_t* o = (bf16_t*)(ws + WS_SUBK);
      for (int i = gt; i < 8 * 256 * 256 / 8; i += NGT) { const int k8 = i & 31, r = (i >> 5) & 255, hh = i >> 13, c = r >> 7, key = r & 127, cp = (k8 * 8) >> 7, d = (k8 * 8) & 127;
          f32x4 a = {0.f, 0.f, 0.f, 0.f}, b = a;
          if (c == cp) { const float* s = sk + ((size_t)((hh * 2 + c) * 128 + key)) * 128 + d; a = *(const f32x4*)s; b = *(const f32x4*)(s + 4); }
          st8_bf16(o + (size_t)i * 8, a, b); } }
    { bf16_t* TT = (bf16_t*)(ws + WS_TT); bf16_t* F1 = (bf16_t*)(ws + WS_F1); bf16_t* F2 = (bf16_t*)(ws + WS_F2);
      for (int i = gt; i < 65536; i += NGT) {
          { const int jp = i >> 8, j = i & 255; float v;
            if (jp <= 128) v = __builtin_amdgcn_cosf((float)((j * jp) & 255) * (1.0f / 256.0f)); else v = -__builtin_amdgcn_sinf((float)((j * (jp - 128)) & 255) * (1.0f / 256.0f));
            TT[i] = (bf16_t)f2bf(v * (1.0f / 16.0f)); }
          { const int rr = i >> 8, cc = i & 255, rip = rr >> 7, k1 = rr & 127, ri = cc >> 7, n1 = cc & 127; const float ph = (float)((n1 * k1) & 127) * (1.0f / 128.0f);
            const float cs = __builtin_amdgcn_cosf(ph), sn = __builtin_amdgcn_sinf(ph);
            const float v = (rip == 0) ? (ri == 0 ? cs : sn) : (ri == 0 ? -sn : cs);
            F1[i] = (bf16_t)f2bf(v * 0.08838834764831845f); }
          if (i < 32768) { const int k2 = i >> 7, cc = i & 127, ri = cc >> 6, n2 = cc & 63; float v = 0.f;
            if (k2 < 64) { const float ph = (float)((n2 * k2) & 63) * (1.0f / 64.0f); v = (ri == 0 ? __builtin_amdgcn_cosf(ph) : __builtin_amdgcn_sinf(ph)) * 0.125f; }
            F2[i] = (bf16_t)f2bf(v); }
      } }
    { const float* g1 = inptr(1); f32x4 gv[8]; float gm = 0.f;
#pragma unroll
      for (int j = 0; j < 8; ++j) { gv[j] = *(const f32x4*)(g1 + (64 * j + lane) * 4); gm = fmaxf(gm, fmaxf(fmaxf(fabsf(gv[j][0]), fabsf(gv[j][1])), fmaxf(fabsf(gv[j][2]), fabsf(gv[j][3])))); }
      const float sx = exp2f((float)xn8_exp(wave_max(gm)));
      const float* X0 = inptr(0);
#define XN_LOAD(V, m) do { const f32x4* xr_ = (const f32x4*)(X0 + (size_t)(m) * DM) + lane; _Pragma("unroll") for (int j = 0; j < 8; ++j) V[j] = xr_[64 * j]; } while (0)
#define XN_STORE(V, m) do { float s_ = 0.f; _Pragma("unroll") for (int j = 0; j < 8; ++j) s_ += (V[j][0] * V[j][0] + V[j][1] * V[j][1]) + (V[j][2] * V[j][2] + V[j][3] * V[j][3]); \
          const float rstd_ = 1.0f / sqrtf(wave_sum(s_) * (1.0f / DM) + EPS); \
          u32x2* o8_ = (u32x2*)((bf16_t*)(ws + WS_XN) + (size_t)(m) * DM) + lane; \
          _Pragma("unroll") for (int j = 0; j < 8; ++j) { const f32x4 y = V[j] * rstd_ * gv[j]; u32x2 w; w.x = cvt_pk_bf16(y[0], y[1]); w.y = cvt_pk_bf16(y[2], y[3]); o8_[64 * j] = w; \
              int w8 = __builtin_amdgcn_cvt_pk_fp8_f32(y[0] * sx, y[1] * sx, 0, false); w8 = __builtin_amdgcn_cvt_pk_fp8_f32(y[2] * sx, y[3] * sx, w8, true); \
              ((unsigned*)(ws + WS_XN8 + (size_t)(m) * DM))[64 * j + lane] = (unsigned)w8; } } while (0)
      f32x4 xa[8], xb[8];
      if (gw < NTOK) XN_LOAD(xa, gw);
      for (int m = gw; m < NTOK; m += 2 * NGW) {
          const bool h1 = m + NGW < NTOK;
          if (h1) XN_LOAD(xb, m + NGW);
          XN_STORE(xa, m);
          if (!h1) break;
          if (m + 2 * NGW < NTOK) XN_LOAD(xa, m + 2 * NGW);
          XN_STORE(xb, m + NGW);
      }
#undef XN_LOAD
#undef XN_STORE
    }
}
typedef float f32x2 __attribute__((ext_vector_type(2)));
__device__ __forceinline__ void convert_experts(const Ptrs& P) {
    int tid_ = P.wid0 * 64 + lane_id(); asm volatile("" : "+v"(tid_));
    const int lane = tid_ & 63, wid = __builtin_amdgcn_readfirstlane(tid_ >> 6);
    const float* eu = inptr(16); const float* ev = inptr(17);
    unsigned char* ou = P.ws + WS_EU; unsigned char* ov = P.ws + WS_EV; float* esc = (float*)(P.ws + WS_ESC);
    unsigned* qh = (unsigned*)(P.ws + WS_CTL) + CW_CVTQ;
    for (;;) {
        unsigned c0 = 0u; if (lane == 0) c0 = atomicAdd(qh, 1u);
        const int chunk = __builtin_amdgcn_readfirstlane((int)c0);
        if (chunk >= 4096) break;
      for (int r = chunk * 8; r < chunk * 8 + 8; ++r) {
        const int tbl = r >> 14, row = r & 16383; const float* s = (tbl ? ev : eu) + (size_t)row * DM + 32 * lane;
        f32x4 v[8]; float am = 0.f;
#pragma unroll
        for (int q = 0; q < 8; ++q) { v[q] = *(const f32x4*)(s + 4 * q);
#pragma unroll
            for (int x = 0; x < 4; ++x) am = fmaxf(am, fabsf(v[q][x])); }
        am = wave_max(am);
        const float sc = am > 1e-30f ? 6.0f / am : 1.0f, inv = am > 1e-30f ? am * (1.0f / 6.0f) : 1.0f;
        u32x4 w;
#pragma unroll
        for (int d = 0; d < 4; ++d) { unsigned t = 0u; const f32x4 a = v[2 * d] * sc, b = v[2 * d + 1] * sc;
            t = __builtin_amdgcn_cvt_scalef32_pk_fp4_f32(t, a[0], a[1], 1.0f, 0); t = __builtin_amdgcn_cvt_scalef32_pk_fp4_f32(t, a[2], a[3], 1.0f, 1);
            t = __builtin_amdgcn_cvt_scalef32_pk_fp4_f32(t, b[0], b[1], 1.0f, 2); t = __builtin_amdgcn_cvt_scalef32_pk_fp4_f32(t, b[2], b[3], 1.0f, 3);
            w[d] = t; }
        *(u32x4*)((tbl ? ov : ou) + (size_t)row * 1024 + 16 * lane) = w;
        if (lane == 0) esc[tbl * 16384 + row] = inv;
      }
    }
}

namespace peer {
__device__ __forceinline__ unsigned f2key(float f) { const unsigned u = __float_as_uint(f); return (u & 0x80000000u) ? ~u : (u | 0x80000000u); }
__device__ __forceinline__ float key2f(unsigned k) { const unsigned u = (k & 0x80000000u) ? (k & 0x7fffffffu) : ~k; return __uint_as_float(u); }
template <int CTRL> __device__ __forceinline__ unsigned dppu(unsigned x) { return (unsigned)__builtin_amdgcn_update_dpp(0, (int)x, CTRL, 0xF, 0xF, false); }
__device__ __forceinline__ unsigned umax_(unsigned a, unsigned b) { return a > b ? a : b; }
__device__ __forceinline__ unsigned rowmax16(unsigned x) {
    x = umax_(x, dppu<0xB1>(x)); x = umax_(x, dppu<0x4E>(x)); x = umax_(x, dppu<0x141>(x)); x = umax_(x, dppu<0x140>(x)); return x;
}
template <int CTRL, int RM> __device__ __forceinline__ float dpp_add(float v) { const int t = __builtin_amdgcn_update_dpp(0, __float_as_int(v), CTRL, RM, 0xF, true); return v + __int_as_float(t); }
__device__ __forceinline__ float wave_sum63(float v) {
    v = dpp_add<0x111, 0xF>(v); v = dpp_add<0x112, 0xF>(v); v = dpp_add<0x114, 0xF>(v); v = dpp_add<0x118, 0xF>(v);
    v = dpp_add<0x142, 0xA>(v); v = dpp_add<0x143, 0xC>(v); return v;
}
template <int CTRL, int RM> __device__ __forceinline__ float dpp_max0(float v) { const int t = __builtin_amdgcn_update_dpp(0, __float_as_int(v), CTRL, RM, 0xF, true); return fmaxf(v, __int_as_float(t)); }
__device__ __forceinline__ float wave_max63(float v) {
    v = dpp_max0<0x111, 0xF>(v); v = dpp_max0<0x112, 0xF>(v); v = dpp_max0<0x114, 0xF>(v); v = dpp_max0<0x118, 0xF>(v);
    v = dpp_max0<0x142, 0xA>(v); v = dpp_max0<0x143, 0xC>(v); return v;
}
__device__ __forceinline__ float gelu_erf(float v) { return 0.5f * v * (1.0f + erff(v * 0.70710678118654752f)); }

__device__ __forceinline__ void peer_phase(const Ptrs& P, LAS unsigned char* lds) {
    int tid_ = P.wid0 * 64 + lane_id(); asm volatile("" : "+v"(tid_));
    const int tid = tid_, lane0 = tid & 63, wid = __builtin_amdgcn_readfirstlane(tid >> 6);
    const int gw = blockIdx.x * 8 + wid, NGW = gridDim.x * 8;
    LAS int* pidx = (LAS int*)(lds + wid * 1024); LAS float* pgate = (LAS float*)(lds + wid * 1024 + 512);
    LAS unsigned char* xq = lds + 8192 + wid * 2048;
    const float* SC = (const float*)(P.ws + WS_SC); const unsigned char* EU = P.ws + WS_EU; const unsigned char* EV = P.ws + WS_EV; const float* ESC = (const float*)(P.ws + WS_ESC);
    const float* g2 = inptr(13); float* OUT = P.out;
    int cpk[4];
#pragma unroll
    for (int x = 0; x < 4; ++x) { const int sl = 4 * (lane0 & 15) + x; int v = 0, pre = 0;
        for (int i = 0; i < 16; ++i) { const int cnt = 16 / (i + 1); if (sl >= pre && sl < pre + cnt) v = i | ((sl - pre) << 4) | 256; pre += cnt; }
        cpk[x] = v; }
    for (int tok = gw; tok < NTOK; tok += NGW) {
        int lane = lane0; asm volatile("" : "+v"(lane));
        const int half = lane >> 5, li = lane & 31;
        float hres[32]; float rstd, xdq;
        { const float* hp = OUT + (size_t)tok * DM + lane; float s = 0.f;
#pragma unroll
          for (int q = 0; q < 32; ++q) hres[q] = __builtin_nontemporal_load(hp + 64 * q);
#pragma unroll
          for (int q = 0; q < 32; q += 4) s += (hres[q] * hres[q] + hres[q + 1] * hres[q + 1]) + (hres[q + 2] * hres[q + 2] + hres[q + 3] * hres[q + 3]);
          rstd = 1.0f / sqrtf(__int_as_float(__builtin_amdgcn_readlane(__float_as_int(wave_sum63(s)), 63)) * (1.0f / DM) + EPS);
          float hn[32], am = 0.f;
#pragma unroll
          for (int q = 0; q < 32; ++q) { hn[q] = hres[q] * rstd * g2[64 * q + lane]; am = fmaxf(am, fabsf(hn[q])); }
          am = __int_as_float(__builtin_amdgcn_readlane(__float_as_int(wave_max63(am)), 63));
          const float qs = am > 1e-30f ? 256.0f / am : 1.0f; xdq = am > 1e-30f ? am * (1.0f / 256.0f) : 1.0f;
#pragma unroll
          for (int q = 0; q < 32; ++q) { const int t = __builtin_amdgcn_cvt_pk_fp8_f32(hn[q] * qs, 0.f, 0, false); xq[64 * q + lane] = (unsigned char)(t & 0xFF); } }
        const int rho = lane >> 4, i16 = lane & 15, rbase = lane & 32;
#define CE(a, b) do { const unsigned hi_ = umax_(a, b), lo_ = (a) < (b) ? (a) : (b); a = hi_; b = lo_; } while (0)
        unsigned k[4][8], selA[4] = {0u, 0u, 0u, 0u};
#pragma unroll
        for (int q = 0; q < 4; ++q) {
            const float* sp = SC + (size_t)tok * DM + (2 * q + (rho >> 1)) * 256 + (rho & 1) * 128 + i16 * 8;
            const f32x4 s0 = __builtin_nontemporal_load((const f32x4*)sp), s1 = __builtin_nontemporal_load((const f32x4*)(sp + 4));
#pragma unroll
            for (int x = 0; x < 4; ++x) { k[q][x] = (f2key(s0[x]) & ~0x7Fu) | (unsigned)(127 - (i16 * 8 + x)); k[q][4 + x] = (f2key(s1[x]) & ~0x7Fu) | (unsigned)(127 - (i16 * 8 + 4 + x)); }
            CE(k[q][0], k[q][1]); CE(k[q][2], k[q][3]); CE(k[q][4], k[q][5]); CE(k[q][6], k[q][7]);
            CE(k[q][0], k[q][2]); CE(k[q][1], k[q][3]); CE(k[q][4], k[q][6]); CE(k[q][5], k[q][7]);
            CE(k[q][1], k[q][2]); CE(k[q][5], k[q][6]); CE(k[q][0], k[q][4]); CE(k[q][3], k[q][7]);
            CE(k[q][1], k[q][5]); CE(k[q][2], k[q][6]);
            CE(k[q][1], k[q][4]); CE(k[q][3], k[q][6]);
            CE(k[q][2], k[q][4]); CE(k[q][3], k[q][5]);
            CE(k[q][3], k[q][4]);
        }
#pragma unroll 1
        for (int r = 0; r < 16; ++r) {
#pragma unroll
            for (int q = 0; q < 4; ++q) {
                const unsigned m = rowmax16(k[q][0]);
                const bool hit = k[q][0] == m;
#pragma unroll
                for (int j = 0; j < 7; ++j) k[q][j] = hit ? k[q][j + 1] : k[q][j];
                k[q][7] = hit ? 0u : k[q][7];
                selA[q] = (i16 == r) ? m : selA[q];
            }
        }
        unsigned ck[4][4], selC[4] = {0u, 0u, 0u, 0u};
#pragma unroll
        for (int q = 0; q < 4; ++q) {
#pragma unroll
            for (int x = 0; x < 4; ++x) { const int ci = cpk[x] & 15, cj = (cpk[x] >> 4) & 15;
                const unsigned ka = (unsigned)__shfl((int)selA[q], rbase + ci), kb = (unsigned)__shfl((int)selA[q], rbase + 16 + cj);
                const float csum = key2f(ka & ~0x7Fu) + key2f(kb & ~0x7Fu);
                ck[q][x] = ((cpk[x] & 256) && (rho & 1) == 0) ? ((f2key(csum) & ~0xFFu) | (unsigned)(255 - (ci * 16 + cj))) : 0u; }
            CE(ck[q][0], ck[q][1]); CE(ck[q][2], ck[q][3]); CE(ck[q][0], ck[q][2]); CE(ck[q][1], ck[q][3]); CE(ck[q][1], ck[q][2]);
        }
#pragma unroll 1
        for (int r = 0; r < 16; ++r) {
#pragma unroll
            for (int q = 0; q < 4; ++q) {
                const unsigned m = rowmax16(ck[q][0]);
                const bool hit = ck[q][0] == m;
                ck[q][0] = hit ? ck[q][1] : ck[q][0]; ck[q][1] = hit ? ck[q][2] : ck[q][1]; ck[q][2] = hit ? ck[q][3] : ck[q][2]; ck[q][3] = hit ? 0u : ck[q][3];
                selC[q] = (i16 == r) ? m : selC[q];
            }
        }
#pragma unroll
        for (int q = 0; q < 4; ++q) {
            const int hh = 2 * q + (rho >> 1);
            const int flat = 255 - (int)(selC[q] & 0xFFu), fi = (flat >> 4) & 15, fj = flat & 15;
            const unsigned ea = (unsigned)__shfl((int)selA[q], rbase + fi), eb = (unsigned)__shfl((int)selA[q], rbase + 16 + fj);
            const int eidx = (127 - (int)(ea & 0x7Fu)) * 128 + (127 - (int)(eb & 0x7Fu));
            const float sv = key2f(selC[q] & ~0xFFu) * rstd;
            const float smax = __shfl(sv, rbase);
            const bool act_ = (rho & 1) == 0;
            float e = act_ ? __expf(sv - smax) : 0.f;
            float es = e; es += __shfl_xor(es, 1); es += __shfl_xor(es, 2); es += __shfl_xor(es, 4); es += __shfl_xor(es, 8);
            if (act_) { pidx[hh * 16 + i16] = eidx; pgate[hh * 16 + i16] = e / es; }
        }
#undef CE
        LDS_WAIT(); asm volatile("" ::: "memory");
        const int idxA = pidx[lane], idxB = pidx[64 + lane]; const float gA = pgate[lane], gB = pgate[64 + lane];
        LDS_WAIT(); asm volatile("" ::: "memory");
        const float uiA = ESC[idxA], uiB = ESC[idxB], viA = ESC[16384 + idxA], viB = ESC[16384 + idxB];
        float dA = 0.f, dB = 0.f;
        { const int c16 = lane & 15, g4 = lane >> 4;
          const unsigned xbo = (unsigned)(size_t)(xq + g4 * 16);
          const unsigned slot0 = (unsigned)__builtin_amdgcn_readfirstlane((int)(unsigned)(size_t)(lds + 24576 + wid * 16896));
          const unsigned aoffs = slot0 + (unsigned)((c16 & 7) * 1056 + (c16 >> 3) * 512 + g4 * 16);
          const unsigned dofs = (unsigned)(lane & 31) * 16u; const bool hi32 = (lane & 32) != 0;
          float WA_ = 0.f, WB_ = 0.f; int ridx = 0; f32x4 dcc = {0.f, 0.f, 0.f, 0.f};
#define STG(b, h) do { LDS_WAIT(); if ((h) == 0) ridx = pidx[16 * (b) + c16]; \
              _Pragma("unroll") for (int i_ = 0; i_ < 8; ++i_) { const int r0_ = __builtin_amdgcn_readlane(ridx, i_), r1_ = __builtin_amdgcn_readlane(ridx, i_ + 8); \
                  att::glds16(EU, (unsigned)(hi32 ? r1_ : r0_) * 1024u + (unsigned)(h) * 512u + dofs, slot0 + (h) * 8448 + i_ * 1056); } } while (0)
#define MMS(h) do { unsigned ao_ = aoffs + (h) * 8448, xo_ = xbo + (h) * 1024; asm volatile("" : "+v"(ao_), "+v"(xo_)); \
              _Pragma("unroll") for (int k_ = 0; k_ < 8; ++k_) { const u32x4 a_ = *(const LAS u32x4*)(ao_ + k_ * 64), b0_ = *(const LAS u32x4*)(xo_ + k_ * 128), b1_ = *(const LAS u32x4*)(xo_ + k_ * 128 + 64); \
                  const i32x8 bv_ = {(int)b0_[0], (int)b0_[1], (int)b0_[2], (int)b0_[3], (int)b1_[0], (int)b1_[1], (int)b1_[2], (int)b1_[3]}; \
                  const i32x8 av_ = {(int)a_[0], (int)a_[1], (int)a_[2], (int)a_[3], 0, 0, 0, 0}; \
                  dcc = __builtin_amdgcn_mfma_scale_f32_16x16x128_f8f6f4(av_, bv_, dcc, 4, 0, 0, 0x7F7F7F7F, 0, 0x7F7F7F7F); } } while (0)
#define EXTR(b) do { const float t_ = (c16 & 2) ? ((c16 & 1) ? dcc[3] : dcc[2]) : ((c16 & 1) ? dcc[1] : dcc[0]); \
              const bool m_ = (c16 >> 2) == ((b) & 3); WA_ = (m_ && (b) < 4) ? t_ : WA_; WB_ = (m_ && (b) >= 4) ? t_ : WB_; dcc = (f32x4){0.f, 0.f, 0.f, 0.f}; } while (0)
          STG(0, 0);
#pragma unroll 1
          for (int b = 0; b < 7; ++b) {
              STG(b, 1); asm volatile("s_waitcnt vmcnt(8)" ::: "memory"); MMS(0);
              STG(b + 1, 0); asm volatile("s_waitcnt vmcnt(8)" ::: "memory"); MMS(1); EXTR(b);
          }
          STG(7, 1); asm volatile("s_waitcnt vmcnt(8)" ::: "memory"); MMS(0);
          asm volatile("s_waitcnt vmcnt(0)" ::: "memory"); MMS(1); EXTR(7);
#undef STG
#undef MMS
#undef EXTR
          const int src = 16 * (c16 >> 2) + 4 * g4 + (lane & 3);
          dA = __shfl(WA_, src) * xdq; dB = __shfl(WB_, src) * xdq; }
        const float actA = gelu_erf(dA * uiA) * gA * viA, actB = gelu_erf(dB * uiB) * gB * viB;
        { const int c16 = lane & 15, g4 = lane >> 4;
          float amx = fmaxf(fabsf(actA), fabsf(actB)); amx = __int_as_float(__builtin_amdgcn_readlane(__float_as_int(wave_max63(amx)), 63));
          const float qa = amx > 1e-30f ? 256.0f / amx : 1.0f, adq = amx > 1e-30f ? amx * (1.0f / 256.0f) : 1.0f;
          LAS unsigned char* a8 = (LAS unsigned char*)pgate;
          { const int t8 = __builtin_amdgcn_cvt_pk_fp8_f32(actA * qa, actB * qa, 0, false); a8[lane] = (unsigned char)(t8 & 0xFF); a8[64 + lane] = (unsigned char)((t8 >> 8) & 0xFF); }
          LDS_WAIT(); asm volatile("" ::: "memory");
          const u32x4 a0_ = *(const LAS u32x4*)(a8 + 16 * g4), a1_ = *(const LAS u32x4*)(a8 + 64 + 16 * g4);
          const i32x8 av = {(int)a0_[0], (int)a0_[1], (int)a0_[2], (int)a0_[3], (int)a1_[0], (int)a1_[1], (int)a1_[2], (int)a1_[3]};
          unsigned rofs[8];
#pragma unroll
          for (int i = 0; i < 8; ++i) rofs[i] = (unsigned)pidx[16 * i + (lane >> 2)] * 1024u + (unsigned)(((lane & 3) ^ ((lane >> 4) & 3)) * 16);
          const unsigned slot0 = (unsigned)__builtin_amdgcn_readfirstlane((int)(unsigned)(size_t)(lds + 24576 + wid * 16896));
          unsigned ab[4];
#pragma unroll
          for (int c = 0; c < 4; ++c) ab[c] = slot0 + (unsigned)((32 * g4 + c16) * 64 + ((c ^ ((c16 >> 2) & 3)) * 16));
          float* orow = OUT + (size_t)tok * DM + lane;
#define DMAV(t) do { LDS_WAIT(); const unsigned char* vb_ = EV + (size_t)(t) * 64; const unsigned sl_ = slot0 + (unsigned)((t) & 1) * 8448u; \
              _Pragma("unroll") for (int i_ = 0; i_ < 8; ++i_) att::glds16(vb_, rofs[i_], sl_ + i_ * 1024); } while (0)
#define TR4(dst, a, OFF) asm volatile("ds_read_b64_tr_b4 %0, %1 offset:" #OFF : "=&v"(dst) : "v"(a) : "memory")
#define QUAD(c0, res) do { u32x2 r_[8]; \
              TR4(r_[0], ac[c0], 0); TR4(r_[1], ac[c0], 1024); TR4(r_[2], ac[c0], 8); TR4(r_[3], ac[c0], 1032); \
              TR4(r_[4], ac[c0 + 1], 0); TR4(r_[5], ac[c0 + 1], 1024); TR4(r_[6], ac[c0 + 1], 8); TR4(r_[7], ac[c0 + 1], 1032); \
              LDS_WAIT(); __builtin_amdgcn_sched_barrier(0); \
              _Pragma("unroll") for (int j_ = 0; j_ < 4; ++j_) { const i32x8 bv_ = {(int)r_[2 * j_][0], (int)r_[2 * j_][1], (int)r_[2 * j_ + 1][0], (int)r_[2 * j_ + 1][1], 0, 0, 0, 0}; \
                  const f32x4 z_ = {0.f, 0.f, 0.f, 0.f}; \
                  const f32x4 o_ = __builtin_amdgcn_mfma_scale_f32_16x16x128_f8f6f4(av, bv_, z_, 0, 4, 0, 0x7F7F7F7F, 0, 0x7F7F7F7F); \
                  const float s_ = (o_[0] + o_[1]) + (o_[2] + o_[3]);        \
                  res = (g4 == j_) ? s_ : res; } } while (0)
          float outv[32];
          DMAV(0);
#pragma unroll
          for (int t = 0; t < 16; ++t) {
              if (t < 15) { DMAV(t + 1); asm volatile("s_waitcnt vmcnt(8)" ::: "memory"); } else asm volatile("s_waitcnt vmcnt(0)" ::: "memory");
              unsigned ac[4]; const unsigned sb = (unsigned)(t & 1) * 8448u;
#pragma unroll
              for (int c = 0; c < 4; ++c) ac[c] = ab[c] + sb;
              float o0 = 0.f, o1 = 0.f;
              QUAD(0, o0); QUAD(2, o1);
              outv[2 * t] = o0; outv[2 * t + 1] = o1;
          }
#pragma unroll
          for (int q = 0; q < 32; ++q) __builtin_nontemporal_store(hres[q] + outv[q] * (0.25f * adq), orow + 64 * q);
#undef DMAV
#undef TR4
#undef QUAD
        }
        __builtin_amdgcn_sched_barrier(0);
    }
}
}

#define XB_TMO      128
#define XB_XCNT(j)  (256  + 64 * (j))
#define XB_XSUB(j)  (1280 + 64 * (j))
#define XB_XGEN(j)  (2304 + 64 * (j))
#define XB_TOP      3328
#define XB_TOPGEN   3392
#define XCD_BAR_WORDS 3456
#define XB_SPIN_CAP (1u << 24)
__device__ __forceinline__ unsigned xb_ld(unsigned* p)              { return __hip_atomic_load(p, __ATOMIC_RELAXED, __HIP_MEMORY_SCOPE_AGENT); }
__device__ __forceinline__ unsigned xb_add(unsigned* p, unsigned v) { return __hip_atomic_fetch_add(p, v, __ATOMIC_RELAXED, __HIP_MEMORY_SCOPE_AGENT); }
__device__ __forceinline__ unsigned xb_xcc_id() { return (unsigned)__builtin_amdgcn_s_getreg((3 << 11) | 20) & 0xFu; }
#define XB_SPIN(cond, bar) do { unsigned _sp = 0; while (cond) { __builtin_amdgcn_s_sleep(1); \
    if ((++_sp & 255u) == 0u) { if (xb_ld(&(bar)[XB_TMO])) break; if (_sp > XB_SPIN_CAP) { atomicAdd(&(bar)[XB_TMO], 1u); break; } } } } while (0)
struct XcdBarrier { unsigned* bar; unsigned x; volatile LAS unsigned* st; int wid0; };
__device__ __forceinline__ XcdBarrier xcd_barrier_post(unsigned* bar, volatile LAS unsigned* st, int wid0) {
    XcdBarrier b; b.bar = bar; b.x = xb_xcc_id(); b.st = st; b.wid0 = wid0;
    if (wid0 == 0 && lane_id() == 0) (void)xb_add(&bar[XB_XCNT(b.x)], 1u);
    return b;
}
__device__ __forceinline__ void xcd_barrier_complete(unsigned* bar, unsigned x, unsigned& nloc, unsigned& nx) {
    const unsigned G = gridDim.x * gridDim.y * gridDim.z;
    unsigned sum, cnt, mine, sp = 0u;
    for (;;) {
        sum = 0u; cnt = 0u; mine = 0u;
#pragma unroll
        for (unsigned j = 0; j < 16; ++j) { const unsigned c = xb_ld(&bar[XB_XCNT(j)]); sum += c; cnt += (c > 0u) ? 1u : 0u; mine = (j == x) ? c : mine; }
        if (sum == G) break;
        __builtin_amdgcn_s_sleep(1);
        if ((++sp & 255u) == 0u) { if (xb_ld(&bar[XB_TMO])) break; if (sp > XB_SPIN_CAP) { atomicAdd(&bar[XB_TMO], 1u); break; } }
    }
    nloc = mine > 0u ? mine : 1u; nx = cnt > 0u ? cnt : 1u;
}
__device__ __forceinline__ void xcd_barrier(const XcdBarrier& b) {
    asm volatile("s_waitcnt vmcnt(0)" ::: "memory");
    __syncthreads();
    if (b.wid0 == 0 && lane_id() == 0) {
        unsigned* bar = b.bar;
        __builtin_amdgcn_s_waitcnt(0);
        unsigned nloc = b.st[0], nx = b.st[1];
        if (nloc == 0u) { xcd_barrier_complete(bar, b.x, nloc, nx); b.st[0] = nloc; b.st[1] = nx; }
        const unsigned old = xb_add(&bar[XB_XSUB(b.x)], 1u);
        const unsigned gen = old / nloc;
        if (old + 1u == (gen + 1u) * nloc) {
            __builtin_amdgcn_fence(__ATOMIC_RELEASE, "agent");
            asm volatile("s_waitcnt vmcnt(0)" ::: "memory");
            const unsigned og = xb_add(&bar[XB_TOP], 1u);
            const unsigned tg = og / nx;
            if (og + 1u == (tg + 1u) * nx) xb_add(&bar[XB_TOPGEN], 1u);
            else XB_SPIN(xb_ld(&bar[XB_TOPGEN]) == tg, bar);
            __builtin_amdgcn_fence(__ATOMIC_ACQUIRE, "agent");
            xb_add(&bar[XB_XGEN(b.x)], 1u);
            asm volatile("s_waitcnt vmcnt(0)" ::: "memory");
        } else {
            XB_SPIN(xb_ld(&bar[XB_XGEN(b.x)]) == gen, bar);
            __builtin_amdgcn_fence(__ATOMIC_ACQUIRE, "agent");
            asm volatile("s_waitcnt vmcnt(0)" ::: "memory");
        }
    }
    __syncthreads();
}

struct KArgs { const float* in[18]; float* out; unsigned char* ws; int ph_lo, ph_hi; };
#ifndef DBG_NPH
#define DBG_NPH 9
#endif
constexpr int NPHASE = DBG_NPH;

__global__ void __launch_bounds__(512, 2) enc_fwd(KArgs args) {
    extern __shared__ __attribute__((aligned(16))) unsigned char lds_raw[];
    LAS unsigned char* lds = (LAS unsigned char*)lds_raw;
    const int lo = args.ph_lo, hi = args.ph_hi;
    if (hi > 1000) { __threadfence(); cg::this_grid().sync(); }
    Ptrs P; P.ws = args.ws; P.out = args.out; P.wid0 = __builtin_amdgcn_readfirstlane((int)threadIdx.x >> 6);
    const int G = gridDim.x, c = blockIdx.x;
    volatile LAS unsigned* bst = (volatile LAS unsigned*)(lds + LDS_BYTES - 64);
    if (P.wid0 == 0 && lane_id() == 0) { bst[0] = 0u; bst[1] = 0u; }
    __syncthreads();
    XcdBarrier xbar; xbar.bar = (unsigned*)(P.ws + WS_CTL) + CW_BAR; xbar.x = 0; xbar.st = bst; xbar.wid0 = P.wid0;
    if (hi - lo > 2) xbar = xcd_barrier_post((unsigned*)(P.ws + WS_CTL) + CW_BAR, bst, P.wid0);
#ifndef PHASE_MASK
#define PHASE_MASK 0x1ff
#endif
#define IN(k) (((PHASE_MASK >> (k)) & 1) && lo <= (k) && (k) < hi)
#define SEAM(k) do { if (lo <= (k) && (k) + 1 < hi) xcd_barrier(xbar); } while (0)
#define RUN_RM(KIND) do { Sched<KIND> S{G, c, P.ws}; EpiRM<KIND> E{P, 0.f}; g8::gemm_phase<EpiRM<KIND>, Sched<KIND>>(lds, geo_of(KIND), S, E, P.wid0); } while (0)
#define RUN_T(KIND) do { Sched<KIND> S{G, c, P.ws}; EpiT<KIND> E{P, 0.f}; g8::gemm_phase<EpiT<KIND>, Sched<KIND>>(lds, geo_of(KIND), S, E, P.wid0); } while (0)
    if (IN(0)) p0_prologue(P, lds);
    SEAM(0);
    if (IN(1)) {
        { int tid_ = P.wid0 * 64 + lane_id(); asm volatile("" : "+v"(tid_));
          const float sw = exp2f((float)wg8_exp(((const unsigned*)(P.ws + WS_CTL))[CW_GMAX]));
          const bf16_t* src = (const bf16_t*)(P.ws + WS_WTIN) + (size_t)7168 * DM; unsigned char* dst = P.ws + WS_WG8;
          for (int i = blockIdx.x * 512 + tid_; i < 4096 * DM / 8; i += gridDim.x * 512) { f32x4 a, b; ld8_bf16(src + (size_t)i * 8, a, b);
              int w0 = __builtin_amdgcn_cvt_pk_fp8_f32(a[0] * sw, a[1] * sw, 0, false); w0 = __builtin_amdgcn_cvt_pk_fp8_f32(a[2] * sw, a[3] * sw, w0, true);
              int w1 = __builtin_amdgcn_cvt_pk_fp8_f32(b[0] * sw, b[1] * sw, 0, false); w1 = __builtin_amdgcn_cvt_pk_fp8_f32(b[2] * sw, b[3] * sw, w1, true);
              *(u32x2*)(dst + (size_t)i * 8) = (u32x2){(unsigned)w0, (unsigned)w1}; } }
        RUN_RM(K_INPROJ); }
    SEAM(1);
    if (IN(2)) {
        { const int lane = lane_id(); const float* g1 = inptr(1); float gm = 0.f;
          for (int i = lane; i < DM; i += 64) gm = fmaxf(gm, fabsf(g1[i]));
          int fsc_bits = __builtin_amdgcn_readfirstlane(__float_as_int(exp2f(-(float)(xn8_exp(wave_max(gm)) + wg8_exp(((const unsigned*)(P.ws + WS_CTL))[CW_GMAX])))));
          asm volatile("" : "+s"(fsc_bits));
          Sched<K_GATE8> S{G, c, P.ws}; EpiRM<K_GATE8> E{P, __int_as_float(fsc_bits)}; g8::gemm_phase<EpiRM<K_GATE8>, Sched<K_GATE8>>(lds, geo_of(K_GATE8), S, E, P.wid0); }
        VM_WAIT(); __syncthreads();
        RUN_T(K_STEPA); }
    SEAM(2);
    if (IN(3)) { RUN_T(K_STAGE1); VM_WAIT(); __syncthreads();
        { Sched<K_FOLD> S{G, (c + G - 64) % G, P.ws}; EpiRM<K_FOLD> E{P, 0.f}; g8::gemm_phase<EpiRM<K_FOLD>, Sched<K_FOLD>>(lds, geo_of(K_FOLD), S, E, P.wid0); } }
    SEAM(3);
    if (IN(4)) {
#ifndef DBG_NO_ST2
        RUN_T(K_STAGE2); VM_WAIT(); __syncthreads();
#endif
        const int lane = lane_id();
        const float s1 = wave_sum(inptr(7)[lane] * inptr(8)[lane] + inptr(7)[lane + 64] * inptr(8)[lane + 64]);
        const float s2 = wave_sum(inptr(9)[lane] * inptr(10)[lane] + inptr(9)[lane + 64] * inptr(10)[lane + 64]);
        const int lam_bits = __builtin_amdgcn_readfirstlane(__float_as_int(__expf(s1) - __expf(s2) + LAM_INIT));
        const float mq = wave_max(fmaxf(fabsf(inptr(5)[lane]), fabsf(inptr(5)[lane + 64]))), mk = wave_max(fmaxf(fabsf(inptr(6)[lane]), fabsf(inptr(6)[lane + 64])));
        const int Mb_bits = __builtin_amdgcn_readfirstlane(__float_as_int(11.313708498984761f * mq * mk * 1.15f));
        const int scl_bits = __builtin_amdgcn_readfirstlane(((127 - fp8_exp(mq, 0.08838834764831845f * LOG2E)) & 0xFF) | (((127 - fp8_exp(mk, 1.0f)) & 0xFF) << 8));
        unsigned* qhead = (unsigned*)(P.ws + WS_CTL) + CW_ATTQ;
        LAS int* ubox = (LAS int*)(lds + att::L_WS + 2048 - 16);
        const int xcc = (int)(xb_xcc_id() & 7u);
#ifndef DBG_NO_ATT
        for (int dq_ = 0; dq_ < 8; ++dq_) {
            const int q = (xcc + dq_) & 7;
            for (;;) {
                if (P.wid0 == 0 && lane == 0) ubox[0] = (int)atomicAdd(qhead + 64 * q, 1u);
                __syncthreads();
                const int u = __builtin_amdgcn_readfirstlane(ubox[0]);
                __syncthreads();
                if (u >= 64) break;
                att::attn_unit(q * 64 + u, P, lds, lam_bits, Mb_bits, scl_bits);
            }
        }
#endif
        convert_experts(P);
    }
    SEAM(4);
    if (IN(5)) { RUN_RM(K_YA); VM_WAIT(); __syncthreads(); RUN_RM(K_YF); }
    SEAM(5);
    if (IN(6)) RUN_RM(K_OUT);
    SEAM(6);
    if (IN(7)) RUN_RM(K_SC);
    SEAM(7);
    if (IN(8)) peer::peer_phase(P, lds);
}

extern "C" void kernel_launch(void* const* d_in, const int* in_sizes, int n_in, void* d_out, int out_size, void* d_ws, size_t ws_size, hipStream_t stream) {
    static int grid = 0;
    if (grid == 0) {
        if (n_in != 18 || in_sizes[0] != NTOK * DM || out_size != NTOK * DM || ws_size < WS_END) {
            fprintf(stderr, "kernel_launch: shape mismatch (n_in %d, in0 %d, out %d, ws %zu)\n", n_in, n_in > 0 ? in_sizes[0] : -1, out_size, ws_size); grid = -1; return; }
        int dev = 0, cus = 0, per_cu = 0;
        hipGetDevice(&dev); hipDeviceGetAttribute(&cus, hipDeviceAttributeMultiprocessorCount, dev);
        if (hipFuncSetAttribute((const void*)enc_fwd, hipFuncAttributeMaxDynamicSharedMemorySize, LDS_BYTES) != hipSuccess) { fprintf(stderr, "kernel_launch: hipFuncSetAttribute failed\n"); grid = -1; return; }
        if (hipOccupancyMaxActiveBlocksPerMultiprocessor(&per_cu, (const void*)enc_fwd, 512, LDS_BYTES) != hipSuccess || per_cu < 1) { fprintf(stderr, "kernel_launch: occupancy query gives %d\n", per_cu); per_cu = 1; }
        (void)hipGetLastError();
        grid = cus;
    }
    if (grid < 0) return;
    hipMemsetAsync((char*)d_ws + WS_CTL, 0, CTL_BYTES, stream);
    KArgs a{};
    for (int i = 0; i < 18; ++i) a.in[i] = (const float*)d_in[i];
    a.out = (float*)d_out; a.ws = (unsigned char*)d_ws;
#if MK_ONE_LAUNCH
    a.ph_lo = 0; a.ph_hi = NPHASE;
    void* kargs[] = {&a};
    hipError_t e = hipLaunchCooperativeKernel((const void*)enc_fwd, dim3(grid), dim3(512), kargs, LDS_BYTES, stream);
    if (e != hipSuccess) fprintf(stderr, "cooperative launch failed: %s (grid %d)\n", hipGetErrorString(e), grid);
#else
#ifndef DBG_SEQ
#define DBG_SEQ "012345678"
#endif
    const char* seq = DBG_SEQ;
    for (int i = 0; seq[i]; ++i) {
        const int ph = seq[i] - '0';
        if (ph == 4) hipMemsetAsync((char*)d_ws + WS_CTL, 0, CTL_BYTES, stream);
        a.ph_lo = ph; a.ph_hi = ph + 1;
        hipLaunchKernelGGL(enc_fwd, dim3(grid), dim3(512), LDS_BYTES, stream, a);
    }
    const hipError_t le = hipPeekAtLastError();
    if (le != hipSuccess) fprintf(stderr, "kernel_launch: launch failed: %s\n", hipGetErrorName(le));
#endif
}
```

```cpp
#include <hip/hip_runtime.h>
#include <hip/hip_cooperative_groups.h>
#include <cstdio>
#include <cstdint>
namespace cg = cooperative_groups;


#ifndef MK_ONE_LAUNCH
#define MK_ONE_LAUNCH 1
#endif

#define LAS __attribute__((address_space(3)))
typedef unsigned short bf16_t;
typedef short bf16x8 __attribute__((ext_vector_type(8)));
typedef short s16x4 __attribute__((ext_vector_type(4)));
typedef float f32x4 __attribute__((ext_vector_type(4)));
typedef float f32x16 __attribute__((ext_vector_type(16)));
typedef unsigned u32x4 __attribute__((ext_vector_type(4)));
typedef int i32x8 __attribute__((ext_vector_type(8)));
typedef unsigned u32x2 __attribute__((ext_vector_type(2)));

constexpr int NTOK = 16384, DM = 2048, SEQ = 8192, NBATCH = 2, INW = 11264;
constexpr float EPS = 1e-6f;
constexpr float LAM_INIT = 0.2f;
constexpr float LOG2E = 1.4426950408889634f;
constexpr int NKC = 129;

constexpr size_t MiB = 1u << 20;
constexpr size_t WS_CTL = 0, CTL_BYTES = 65536;
constexpr size_t WS_TT = 1 * MiB + 64 * 1024, WS_F1 = 1 * MiB + 192 * 1024, WS_F2 = 1 * MiB + 320 * 1024;
constexpr size_t WS_ESC = 1 * MiB + 512 * 1024;
constexpr size_t WS_SUBK = 2 * MiB;
constexpr size_t WS_WTIN = 4 * MiB, WS_A1 = WS_WTIN;
constexpr size_t WS_EU = WS_WTIN, WS_EV = WS_WTIN + 16 * MiB;
constexpr size_t WS_WTF = 48 * MiB, WS_WTA = 52 * MiB, WS_WTO = 60 * MiB, WS_WQ16 = 68 * MiB, WS_WTS = 76 * MiB;
constexpr size_t WS_XN = 84 * MiB, WS_A2 = WS_XN, WS_MIXED = WS_XN;
constexpr size_t WS_ZF = 148 * MiB, WS_YF = WS_ZF;
constexpr size_t WS_Q = 180 * MiB, WS_O = WS_Q, WS_HG = WS_Q;
constexpr size_t WS_XN8 = 180 * MiB, WS_WG8 = 212 * MiB;
constexpr size_t WS_K = 244 * MiB, WS_Q8 = WS_K + 32 * MiB;
constexpr size_t WS_V = 308 * MiB;
constexpr size_t WS_GF = 372 * MiB, WS_SC = WS_GF;
constexpr size_t WS_GA = 436 * MiB;
constexpr size_t WS_END = 500 * MiB;
constexpr int CW_ATTQ = 64;
constexpr int CW_GMAX = 704;
constexpr int CW_CVTQ = 640;
constexpr int CW_BAR = 1024;

constexpr int RING_BYTES = 131072;
constexpr int EPI_OFF = RING_BYTES;
constexpr int LDS_BYTES = 163840;

__device__ __forceinline__ unsigned cvt_pk_bf16(float lo, float hi) { unsigned r; asm volatile("v_cvt_pk_bf16_f32 %0, %1, %2" : "=v"(r) : "v"(lo), "v"(hi)); return r; }
__device__ __forceinline__ float bf_lo(unsigned w) { return __uint_as_float(w << 16); }
__device__ __forceinline__ float bf_hi(unsigned w) { return __uint_as_float(w & 0xffff0000u); }
__device__ __forceinline__ float wave_sum(float v) {
#pragma unroll
    for (int o = 1; o < 64; o <<= 1) v += __shfl_xor(v, o);
    return v;
}
__device__ __forceinline__ float wave_max(float v) {
#pragma unroll
    for (int o = 1; o < 64; o <<= 1) v = fmaxf(v, __shfl_xor(v, o));
    return v;
}
#define LDS_WAIT() asm volatile("s_waitcnt lgkmcnt(0)" ::: "memory")
#define VM_WAIT() asm volatile("s_waitcnt vmcnt(0)" ::: "memory")

__device__ __forceinline__ void glds16_(const void* gbase, unsigned voff, unsigned lds_dst) { unsigned keep;
    asm volatile("s_mov_b32 %0, m0\n\ts_mov_b32 m0, %3\n\ts_nop 0\n\tglobal_load_lds_dwordx4 %1, %2\n\ts_mov_b32 m0, %0" : "=&s"(keep) : "v"(voff), "s"(gbase), "s"(lds_dst) : "memory"); }
namespace g8 {
constexpr int BM = 256, BK = 64, HALF = 128, HTB = HALF * BK * 2;
__host__ __device__ __forceinline__ int lds_byte(int r, int c) { const int st = (r >> 4) * 2 + (c >> 5), rr = r & 15, cc = c & 31, ob = rr * 64 + cc * 2; return st * 1024 + (ob ^ (((ob >> 9) & 1) << 5)); }
__host__ __device__ __forceinline__ void stage_rc(int b, int& R, int& C) { const int st = b / 1024, sb = b % 1024, swz = sb ^ (((sb >> 9) & 1) << 5); R = (st >> 1) * 16 + swz / 64; C = (st & 1) * 32 + (swz % 64) / 2; }
__host__ __device__ __forceinline__ int perm32(int rho) { const int n = rho >> 4, i = rho & 15; return 8 * (i >> 2) + 4 * n + (i & 3); }

struct Unit { const char* a; const char* b; int pm, pn, aux; };
struct Geo { int K; unsigned rowA, halfA, rowB, halfB; };

template <class Epi, class Sched>
__device__ __forceinline__ void gemm_phase(LAS unsigned char* lds, const Geo g, const Sched& S, const Epi& E, int wid0) {
    int tid_ = wid0 * 64 + (int)__builtin_amdgcn_mbcnt_hi(~0u, __builtin_amdgcn_mbcnt_lo(~0u, 0u)); asm volatile("" : "+v"(tid_));
    const int tid = tid_, wid = __builtin_amdgcn_readfirstlane(tid >> 6), lane = tid & 63, wr = wid >> 2, wc = wid & 3, fr = lane & 15, fq = lane >> 4;
    const int nt = g.K / BK;
    unsigned voffA[2], voffB[2];
#pragma unroll
    for (int i = 0; i < 2; ++i) { int R, C; stage_rc(tid * 16 + i * 8192, R, C); const int Rb = Epi::PERM ? ((R & ~31) + perm32(R & 31)) : R;
        voffA[i] = (unsigned)R * g.rowA + (unsigned)C * 2u; voffB[i] = (unsigned)Rb * g.rowB + (unsigned)C * 2u; }
    const size_t kstep = (size_t)(BK * 2);
    const size_t hA = g.halfA, hB = g.halfB;
    const unsigned ldsw = (unsigned)wid * 1024u; const unsigned ldsb = (unsigned)__builtin_amdgcn_readfirstlane((int)((unsigned)(size_t)lds + ldsw));
    const int aoff = lds_byte(wr * 64 + fr, fq * 8), boff = lds_byte(wc * 32 + fr, fq * 8);
#define G8_SA(b, h) (((b) * 2 + (h)) * HTB)
#define G8_SB(b, h) ((4 + (b) * 2 + (h)) * HTB)
#define G8_STAGE(bufoff, gbase, voff) do { _Pragma("unroll") for (int _i = 0; _i < 2; ++_i) \
        glds16_((const char*)(gbase), (voff)[_i], ldsb + (unsigned)((bufoff) + _i * 8192)); } while (0)
#define G8_LDA(dst, b, h) do { _Pragma("unroll") for (int m = 0; m < 4; ++m) _Pragma("unroll") for (int k = 0; k < 2; ++k) dst[m][k] = *(const LAS bf16x8*)(lds + G8_SA(b, h) + aoff + m * 2048 + k * 1024); } while (0)
#define G8_LDB(dst, b, h) do { _Pragma("unroll") for (int n = 0; n < 2; ++n) _Pragma("unroll") for (int k = 0; k < 2; ++k) dst[n][k] = *(const LAS bf16x8*)(lds + G8_SB(b, h) + boff + n * 2048 + k * 1024); } while (0)
#define G8_P8(X0, X1) ([&]() { const u32x4 a_ = __builtin_bit_cast(u32x4, X0), b_ = __builtin_bit_cast(u32x4, X1); return (i32x8){(int)a_[0], (int)a_[1], (int)a_[2], (int)a_[3], (int)b_[0], (int)b_[1], (int)b_[2], (int)b_[3]}; }())
#define G8_MMA(ai, bj, At, Bt) do { __builtin_amdgcn_s_setprio(1); \
        if constexpr (Epi::FP8) { _Pragma("unroll") for (int m = 0; m < 4; ++m) _Pragma("unroll") for (int n = 0; n < 2; ++n) \
            acc[ai][bj][m][n] = __builtin_amdgcn_mfma_scale_f32_16x16x128_f8f6f4(G8_P8(Bt[n][0], Bt[n][1]), G8_P8(At[m][0], At[m][1]), acc[ai][bj][m][n], 0, 0, 0, 0, 0, 0); } \
        else { _Pragma("unroll") for (int m = 0; m < 4; ++m) _Pragma("unroll") for (int n = 0; n < 2; ++n) _Pragma("unroll") for (int k = 0; k < 2; ++k) \
        acc[ai][bj][m][n] = Epi::SWAP ? __builtin_amdgcn_mfma_f32_16x16x32_bf16(Bt[n][k], At[m][k], acc[ai][bj][m][n], 0, 0, 0) \
                                      : __builtin_amdgcn_mfma_f32_16x16x32_bf16(At[m][k], Bt[n][k], acc[ai][bj][m][n], 0, 0, 0); } __builtin_amdgcn_s_setprio(0); } while (0)
#define G8_WAIT_V(n) asm volatile("s_waitcnt vmcnt(" #n ")" ::: "memory")
#define G8_WAIT_L(n) asm volatile("s_waitcnt lgkmcnt(" #n ")" ::: "memory")
#define G8_BAR __builtin_amdgcn_s_barrier()
#define G8_SCHED __builtin_amdgcn_sched_barrier(0)
    Unit cur, nxt; int ui = 0;
    if (!S.next(0, cur)) return;
    f32x4 acc[2][2][4][2];
#pragma unroll
    for (int a = 0; a < 2; ++a)
#pragma unroll
        for (int b = 0; b < 2; ++b)
#pragma unroll
            for (int m = 0; m < 4; ++m)
#pragma unroll
                for (int n = 0; n < 2; ++n) acc[a][b][m][n] = (f32x4){0.f, 0.f, 0.f, 0.f};
    bf16x8 At[4][2], B0[2][2], B1[2][2];
    const char* cA = cur.a; const char* cB = cur.b;
    G8_STAGE(G8_SB(0, 0), cB, voffB); G8_STAGE(G8_SB(0, 1), cB + hB, voffB); G8_STAGE(G8_SA(0, 0), cA, voffA); G8_STAGE(G8_SA(0, 1), cA + hA, voffA);
    if (wr == 1) G8_BAR;
    G8_WAIT_V(2); G8_BAR;
    G8_STAGE(G8_SB(1, 0), cB + kstep, voffB); G8_STAGE(G8_SA(1, 0), cA + kstep, voffA); G8_STAGE(G8_SB(1, 1), cB + hB + kstep, voffB);
    G8_WAIT_V(6); G8_BAR;
    for (;;) {
        const bool has_next = S.next(ui + 1, nxt);
        const char* nA = has_next ? nxt.a : cA; const char* nB = has_next ? nxt.b : cB;
        for (int t = 0; t < nt; t += 2) {
            const bool last = (t == nt - 2);
            const char* a1 = cA + (size_t)(t + 1) * kstep;
            const char* a2 = last ? nA : cA + (size_t)(t + 2) * kstep; const char* b2 = last ? nB : cB + (size_t)(t + 2) * kstep;
            const char* a3 = a2 + kstep; const char* b3 = b2 + kstep;
            G8_LDB(B0, 0, 0); G8_LDB(B1, 0, 1); G8_SCHED; G8_LDA(At, 0, 0); G8_STAGE(G8_SA(1, 1), a1 + hA, voffA);
            G8_WAIT_V(8); G8_WAIT_L(0); G8_BAR; G8_MMA(0, 0, At, B0); G8_MMA(0, 1, At, B1); G8_BAR; G8_SCHED;
            G8_LDA(At, 0, 1); G8_STAGE(G8_SB(0, 0), b2, voffB); G8_STAGE(G8_SB(0, 1), b2 + hB, voffB); G8_STAGE(G8_SA(0, 0), a2, voffA);
            G8_WAIT_V(8); G8_WAIT_L(0); G8_BAR; G8_MMA(1, 0, At, B0); G8_MMA(1, 1, At, B1); G8_BAR; G8_SCHED;
            G8_LDB(B0, 1, 0); G8_LDB(B1, 1, 1); G8_SCHED; G8_LDA(At, 1, 0); G8_STAGE(G8_SA(0, 1), a2 + hA, voffA);
            G8_WAIT_V(8); G8_WAIT_L(0); G8_BAR; G8_MMA(0, 0, At, B0); G8_MMA(0, 1, At, B1); G8_BAR; G8_SCHED;
            G8_LDA(At, 1, 1); G8_STAGE(G8_SB(1, 0), b3, voffB); G8_STAGE(G8_SB(1, 1), b3 + hB, voffB); G8_STAGE(G8_SA(1, 0), a3, voffA);
            G8_WAIT_V(8); G8_WAIT_L(0); G8_BAR; G8_MMA(1, 0, At, B0); G8_MMA(1, 1, At, B1); G8_BAR; G8_SCHED;
        }
        if (wr == 0) G8_BAR;
        E(acc, cur, wr, wc, fr, fq, lds + EPI_OFF);
        if (!has_next) break;
#pragma unroll
        for (int a = 0; a < 2; ++a)
#pragma unroll
            for (int b = 0; b < 2; ++b)
#pragma unroll
                for (int m = 0; m < 4; ++m)
#pragma unroll
                    for (int n = 0; n < 2; ++n) acc[a][b][m][n] = (f32x4){0.f, 0.f, 0.f, 0.f};
        cur = nxt; cA = nA; cB = nB; ++ui;
        if (wr == 1) G8_BAR;
    }
    G8_WAIT_V(0);
    G8_BAR;
#undef G8_SA
#undef G8_SB
#undef G8_STAGE
#undef G8_LDA
#undef G8_LDB
#undef G8_MMA
#undef G8_P8
}
}

enum { K_INPROJ = 0, K_FOLD, K_YA, K_YF, K_OUT, K_SC, K_STEPA, K_STAGE1, K_STAGE2, K_GATE8 };

struct Ptrs { float* out; unsigned char* ws; int wid0; };
__device__ __forceinline__ int lane_id() { return (int)__builtin_amdgcn_mbcnt_hi(~0u, __builtin_amdgcn_mbcnt_lo(~0u, 0u)); }
__device__ __forceinline__ const float* inptr(int i) {
    const __attribute__((address_space(4))) char* kp = (const __attribute__((address_space(4))) char*)__builtin_amdgcn_kernarg_segment_ptr();
    return *(const float* const __attribute__((address_space(4)))*)(kp + i * 8);
}

__device__ __forceinline__ void tile_order(int L, int nM, int nN, int& pm, int& pn) {
    const int nwg = nM * nN; constexpr int NXCD = 8, WGM = 8;
    int wgid = L; { const int q = nwg / NXCD, r = nwg % NXCD, xcd = wgid % NXCD, off = wgid / NXCD; wgid = (xcd < r ? xcd * (q + 1) : r * (q + 1) + (xcd - r) * q) + off; }
    const int nig = WGM * nN, gid = wgid / nig, fm = gid * WGM, gsz = (nM - fm) < WGM ? (nM - fm) : WGM;
    pm = fm + ((wgid % nig) % gsz); pn = (wgid % nig) / gsz;
}

template <int kind> struct Sched {
    int G, c; unsigned char* ws;
    __device__ __forceinline__ bool next(int i, g8::Unit& u) const {
        const int L = i * G + c;
        switch (kind) {
        case K_GATE8: { if (L >= 64 * 16) return false; tile_order(L, 64, 16, u.pm, u.pn);
            u.a = (const char*)(ws + WS_XN8) + (size_t)u.pm * 256 * DM; u.b = (const char*)(ws + WS_WG8) + (size_t)u.pn * 256 * DM; u.aux = 0; return true; }
        case K_INPROJ: { if (L >= 64 * 28) return false; tile_order(L, 64, 28, u.pm, u.pn);
            u.a = (const char*)(ws + WS_XN) + (size_t)u.pm * 256 * DM * 2; u.b = (const char*)(ws + WS_WTIN) + (size_t)u.pn * 256 * DM * 2; u.aux = 0; return true; }
        case K_FOLD: { if (L >= 64) return false; u.pm = L >> 3; u.pn = L & 7;
            u.a = (const char*)(ws + WS_SUBK) + (size_t)u.pm * 256 * 256 * 2; u.b = (const char*)(ws + WS_WQ16) + ((size_t)u.pn * 256 * DM + (size_t)u.pm * 256) * 2; u.aux = 0; return true; }
        case K_YA: { if (L >= 512) return false; tile_order(L, 64, 8, u.pm, u.pn);
            u.a = (const char*)(ws + WS_O) + (size_t)u.pm * 256 * DM * 2; u.b = (const char*)(ws + WS_WTA) + (size_t)u.pn * 256 * DM * 2; u.aux = 0; return true; }
        case K_YF: { if (L >= 512) return false; tile_order(L, 64, 8, u.pm, u.pn);
            u.a = (const char*)(ws + WS_YF) + (size_t)u.pm * 256 * 1024 * 2; u.b = (const char*)(ws + WS_WTF) + (size_t)u.pn * 256 * 1024 * 2; u.aux = 0; return true; }
        case K_OUT: { if (L >= 512) return false; tile_order(L, 64, 8, u.pm, u.pn);
            u.a = (const char*)(ws + WS_MIXED) + (size_t)u.pm * 256 * DM * 2; u.b = (const char*)(ws + WS_WTO) + (size_t)u.pn * 256 * DM * 2; u.aux = 0; return true; }
        case K_SC: { if (L >= 512) return false; tile_order(L, 64, 8, u.pm, u.pn);
            u.a = (const char*)(ws + WS_HG) + (size_t)u.pm * 256 * DM * 2; u.b = (const char*)(ws + WS_WTS) + (size_t)u.pn * 256 * DM * 2; u.aux = 0; return true; }
        case K_STEPA: { if (L >= 256) return false; const int bg = L >> 5, q = L & 31, b = bg >> 2, gr = bg & 3; u.pm = bg; u.pn = 0; u.aux = q;
            u.a = (const char*)(ws + WS_ZF) + ((size_t)(b * SEQ + 2 * q) * 1024 + gr * 256) * 2; u.b = (const char*)(ws + WS_TT); return true; }
        case K_STAGE1: { if (L >= 258) return false; u.pm = L; u.pn = 0; u.aux = 0;
            u.a = (const char*)(ws + WS_A1) + (size_t)L * 256 * 512; u.b = (const char*)(ws + WS_F1); return true; }
        case K_STAGE2: { if (L >= 516) return false; u.pm = L; u.pn = 0; u.aux = 0;
            u.a = (const char*)(ws + WS_A2) + (size_t)L * 256 * 256; u.b = (const char*)(ws + WS_F2); return true; }
        }
        return false;
    }
};
__host__ __device__ constexpr g8::Geo geo_of(int kind) {
    switch (kind) {
    case K_INPROJ: case K_YA: case K_OUT: case K_SC: return g8::Geo{2048, 4096u, 128u * 4096u, 4096u, 128u * 4096u};
    case K_GATE8: return g8::Geo{1024, 2048u, 128u * 2048u, 2048u, 128u * 2048u};
    case K_FOLD: return g8::Geo{256, 512u, 128u * 512u, 4096u, 128u * 4096u};
    case K_YF: return g8::Geo{1024, 2048u, 128u * 2048u, 2048u, 128u * 2048u};
    case K_STEPA: return g8::Geo{256, 64u * 2048u, 2048u, 512u, 128u * 512u};
    case K_STAGE1: return g8::Geo{256, 512u, 128u * 512u, 512u, 128u * 512u};
    default: return g8::Geo{128, 256u, 128u * 256u, 256u, 128u * 256u};
    }
}

__device__ __forceinline__ void st8_bf16(bf16_t* p, f32x4 v0, f32x4 v1) {
    u32x4 w; w.x = cvt_pk_bf16(v0[0], v0[1]); w.y = cvt_pk_bf16(v0[2], v0[3]); w.z = cvt_pk_bf16(v1[0], v1[1]); w.w = cvt_pk_bf16(v1[2], v1[3]);
    *(u32x4*)p = w;
}
__device__ __forceinline__ void ld8_bf16(const bf16_t* p, f32x4& v0, f32x4& v1) {
    const u32x4 w = *(const u32x4*)p;
    v0 = (f32x4){bf_lo(w.x), bf_hi(w.x), bf_lo(w.y), bf_hi(w.y)}; v1 = (f32x4){bf_lo(w.z), bf_hi(w.z), bf_lo(w.w), bf_hi(w.w)};
}
__device__ __forceinline__ float sigmoidf_(float x) { return 1.0f / (1.0f + __expf(-x)); }

__device__ __forceinline__ int fp8_exp(float maxg, float extra) { return (int)floorf(__log2f(440.0f / (11.32f * fmaxf(maxg, 1e-6f) * extra))); }
__device__ __forceinline__ int xn8_exp(float maxg1) { return (int)floorf(__log2f(440.0f / (45.26f * fmaxf(maxg1, 1e-6f)))); }
__device__ __forceinline__ int wg8_exp(unsigned gmax_bits) { return (int)floorf(__log2f(440.0f / fmaxf(__uint_as_float(gmax_bits), 1e-30f))); }
template <int kind> struct EpiRM {
    static constexpr bool PERM = true, SWAP = true, FP8 = (kind == K_GATE8);
    Ptrs P; float fsc;
    __device__ __forceinline__ void operator()(f32x4 (&acc)[2][2][4][2], const g8::Unit& u, int wr, int wc, int fr_, int fq_, LAS unsigned char* elds) const {
        unsigned char* ws = P.ws;
        int fr = (kind == K_GATE8) ? (lane_id() & 15) : fr_, fq = (kind == K_GATE8) ? (lane_id() >> 4) : fq_; asm volatile("" : "+v"(fr), "+v"(fq));
        const int row0 = u.pm * 256 + wr * 64 + fr;
        const int ct = wc * 32 + 8 * fq;
        if (kind == K_GATE8) {
            const int pn = u.pn;
            bf16_t* O = (bf16_t*)(ws + (pn < 8 ? WS_GF : WS_GA)); const int cbase = (pn & 7) * 256;
#pragma unroll
            for (int ai = 0; ai < 2; ++ai)
#pragma unroll
                for (int m = 0; m < 4; ++m)
#pragma unroll
                    for (int bj = 0; bj < 2; ++bj) {
                        f32x4 a = acc[ai][bj][m][0], b = acc[ai][bj][m][1];
#pragma unroll
                        for (int x = 0; x < 4; ++x) { a[x] = sigmoidf_(a[x] * fsc); b[x] = sigmoidf_(b[x] * fsc); }
                        st8_bf16(O + (size_t)(row0 + ai * 128 + m * 16) * DM + cbase + ct + bj * 128, a, b);
                    }
        } else if (kind == K_INPROJ) {
            const int pn = u.pn;
            if (pn < 4) {
                bf16_t* O = (bf16_t*)(ws + WS_ZF);
#pragma unroll
                for (int ai = 0; ai < 2; ++ai)
#pragma unroll
                    for (int m = 0; m < 4; ++m)
#pragma unroll
                        for (int bj = 0; bj < 2; ++bj) st8_bf16(O + (size_t)(row0 + ai * 128 + m * 16) * 1024 + pn * 256 + ct + bj * 128, acc[ai][bj][m][0], acc[ai][bj][m][1]);
            } else if (pn < 20) {
                const bool isq = pn < 12;
                LAS float* Pl = (LAS float*)elds;
#pragma unroll
                for (int ai = 0; ai < 2; ++ai)
#pragma unroll
                    for (int m = 0; m < 4; ++m)
#pragma unroll
                        for (int bj = 0; bj < 2; ++bj) {
                            const f32x4 a = acc[ai][bj][m][0], b = acc[ai][bj][m][1];
                            float s = (a[0] * a[0] + a[1] * a[1]) + (a[2] * a[2] + a[3] * a[3]) + (b[0] * b[0] + b[1] * b[1]) + (b[2] * b[2] + b[3] * b[3]);
                            s += __shfl_xor(s, 16); s += __shfl_xor(s, 32);
                            if (fq == 0) Pl[((ai * 128 + wr * 64 + m * 16 + fr) * 2 + bj) * 4 + wc] = s;
                        }
                LDS_WAIT(); __builtin_amdgcn_s_barrier(); asm volatile("" ::: "memory");
                const float* gsrc = isq ? inptr(5) : inptr(6);
                const float extra0 = isq ? (0.08838834764831845f * LOG2E) : 1.0f;
                float extra;
                { const int l_ = lane_id(); const float mg = wave_max(fmaxf(fabsf(gsrc[l_]), fabsf(gsrc[l_ + 64]))); extra = extra0 * exp2f((float)fp8_exp(mg, extra0)); }
                const f32x4 g0 = *(const f32x4*)(gsrc + ct) * extra, g1 = *(const f32x4*)(gsrc + ct + 4) * extra;
                unsigned char* O = ws + (isq ? WS_Q8 : WS_K);
                const int cbase = (isq ? (pn - 4) : (pn - 12)) * 256;
#pragma unroll
                for (int ai = 0; ai < 2; ++ai)
#pragma unroll
                    for (int m = 0; m < 4; ++m)
#pragma unroll
                        for (int bj = 0; bj < 2; ++bj) {
                            const f32x4 t = *(const LAS f32x4*)(Pl + ((ai * 128 + wr * 64 + m * 16 + fr) * 2 + bj) * 4);
                            const float rinv = 1.0f / sqrtf(((t[0] + t[1]) + (t[2] + t[3])) * (1.0f / 128.0f) + EPS);
                            const int rw = row0 + ai * 128 + m * 16;
                            unsigned char* dst = isq ? O + (size_t)rw * DM + cbase + ct + bj * 128
                                                     : O + ((size_t)(((rw >> 13) * 16 + (pn - 12) * 2 + bj) * SEQ + (rw & (SEQ - 1)))) * 128 + ct;
                            { const f32x4 v0 = acc[ai][bj][m][0] * rinv * g0, v1 = acc[ai][bj][m][1] * rinv * g1;
                              int w0 = __builtin_amdgcn_cvt_pk_fp8_f32(v0[0], v0[1], 0, false); w0 = __builtin_amdgcn_cvt_pk_fp8_f32(v0[2], v0[3], w0, true);
                              int w1 = __builtin_amdgcn_cvt_pk_fp8_f32(v1[0], v1[1], 0, false); w1 = __builtin_amdgcn_cvt_pk_fp8_f32(v1[2], v1[3], w1, true);
                              *(u32x2*)dst = (u32x2){(unsigned)w0, (unsigned)w1}; }
                        }
                LDS_WAIT(); __builtin_amdgcn_s_barrier(); asm volatile("" ::: "memory");
            } else if (pn < 28) {
                bf16_t* O = (bf16_t*)(ws + WS_V);
#pragma unroll
                for (int ai = 0; ai < 2; ++ai)
#pragma unroll
                    for (int m = 0; m < 4; ++m)
#pragma unroll
                        for (int bj = 0; bj < 2; ++bj) { const int rw = row0 + ai * 128 + m * 16;
                            st8_bf16(O + ((size_t)(((rw >> 13) * 16 + (pn - 20) * 2 + bj) * SEQ + (rw & (SEQ - 1)))) * 128 + ct, acc[ai][bj][m][0], acc[ai][bj][m][1]); }
            }
        } else if (kind == K_FOLD) {
            bf16_t* O = (bf16_t*)(ws + WS_WTS);
#pragma unroll
            for (int ai = 0; ai < 2; ++ai)
#pragma unroll
                for (int m = 0; m < 4; ++m)
#pragma unroll
                    for (int bj = 0; bj < 2; ++bj) st8_bf16(O + (size_t)(row0 + ai * 128 + m * 16) * DM + u.pn * 256 + ct + bj * 128, acc[ai][bj][m][0], acc[ai][bj][m][1]);
        } else if (kind == K_YA || kind == K_YF) {
            bf16_t* O = (bf16_t*)(ws + WS_MIXED); const bf16_t* Gt = (const bf16_t*)(ws + (kind == K_YA ? WS_GA : WS_GF));
#pragma unroll
            for (int ai = 0; ai < 2; ++ai) {
                u32x4 gw_[8], pw_[8];
#pragma unroll
                for (int m = 0; m < 4; ++m)
#pragma unroll
                    for (int bj = 0; bj < 2; ++bj) { const size_t off = (size_t)(row0 + ai * 128 + m * 16) * DM + u.pn * 256 + ct + bj * 128;
                        gw_[m * 2 + bj] = *(const u32x4*)(Gt + off); if (kind == K_YF) pw_[m * 2 + bj] = *(const u32x4*)(O + off); }
#pragma unroll
                for (int m = 0; m < 4; ++m)
#pragma unroll
                    for (int bj = 0; bj < 2; ++bj) {
                        const size_t off = (size_t)(row0 + ai * 128 + m * 16) * DM + u.pn * 256 + ct + bj * 128;
                        const u32x4 w = gw_[m * 2 + bj];
                        const f32x4 g0 = {bf_lo(w.x), bf_hi(w.x), bf_lo(w.y), bf_hi(w.y)}, g1 = {bf_lo(w.z), bf_hi(w.z), bf_lo(w.w), bf_hi(w.w)};
                        f32x4 a = acc[ai][bj][m][0] * g0, b = acc[ai][bj][m][1] * g1;
                        if (kind == K_YF) { const u32x4 q = pw_[m * 2 + bj]; a += (f32x4){bf_lo(q.x), bf_hi(q.x), bf_lo(q.y), bf_hi(q.y)}; b += (f32x4){bf_lo(q.z), bf_hi(q.z), bf_lo(q.w), bf_hi(q.w)}; }
                        st8_bf16(O + off, a, b);
                    }
            }
        } else if (kind == K_OUT) {
            const float* X = inptr(0); float* H = P.out; bf16_t* HG = (bf16_t*)(ws + WS_HG); const float* g2 = inptr(13);
#pragma unroll
            for (int bj = 0; bj < 2; ++bj) {
                const int col = u.pn * 256 + ct + bj * 128;
                const f32x4 ga = *(const f32x4*)(g2 + col), gb = *(const f32x4*)(g2 + col + 4);
                f32x4 xv[8][2];
#pragma unroll
                for (int ai = 0; ai < 2; ++ai)
#pragma unroll
                    for (int m = 0; m < 4; ++m) { const size_t off = (size_t)(row0 + ai * 128 + m * 16) * DM + col; xv[ai * 4 + m][0] = *(const f32x4*)(X + off); xv[ai * 4 + m][1] = *(const f32x4*)(X + off + 4); }
#pragma unroll
                for (int ai = 0; ai < 2; ++ai)
#pragma unroll
                    for (int m = 0; m < 4; ++m) {
                        const size_t off = (size_t)(row0 + ai * 128 + m * 16) * DM + col;
                        const f32x4 h0 = xv[ai * 4 + m][0] + acc[ai][bj][m][0], h1 = xv[ai * 4 + m][1] + acc[ai][bj][m][1];
                        *(f32x4*)(H + off) = h0; *(f32x4*)(H + off + 4) = h1;
                        st8_bf16(HG + off, h0 * ga, h1 * gb);
                    }
            }
        } else {
            float* SC = (float*)(ws + WS_SC);
#pragma unroll
            for (int ai = 0; ai < 2; ++ai)
#pragma unroll
                for (int m = 0; m < 4; ++m)
#pragma unroll
                    for (int bj = 0; bj < 2; ++bj) {
                        const size_t off = (size_t)(row0 + ai * 128 + m * 16) * DM + u.pn * 256 + ct + bj * 128;
                        *(f32x4*)(SC + off) = acc[ai][bj][m][0]; *(f32x4*)(SC + off + 4) = acc[ai][bj][m][1];
                    }
        }
    }
};

template <int kind> struct EpiT {
    static constexpr bool PERM = false, SWAP = false, FP8 = false;
    Ptrs P; float fsc;
    __device__ __forceinline__ void operator()(f32x4 (&acc)[2][2][4][2], const g8::Unit& u, int wr, int wc, int fr_, int fq_, LAS unsigned char* elds) const {
        unsigned char* ws = P.ws;
        int fr = fr_, fq = fq_; asm volatile("" : "+v"(fr), "+v"(fq));
        if (kind == K_STEPA) {
            bf16_t* A1 = (bf16_t*)(ws + WS_A1); const int bg = u.pm, q = u.aux;
#pragma unroll
            for (int ai = 0; ai < 2; ++ai)
#pragma unroll
                for (int bj = 0; bj < 2; ++bj)
#pragma unroll
                    for (int m = 0; m < 4; ++m)
#pragma unroll
                        for (int n = 0; n < 2; ++n) {
                            const int n1 = wr * 64 + m * 16 + 4 * fq, n2 = 2 * q + ai, jp = bj * 128 + wc * 32 + n * 16 + fr;
                            const int kc = jp <= 128 ? jp : jp - 128, ri = jp <= 128 ? 0 : 1;
                            const f32x4 v = acc[ai][bj][m][n];
                            u32x2 w; w.x = cvt_pk_bf16(v[0], v[1]); w.y = cvt_pk_bf16(v[2], v[3]);
                            *(u32x2*)(A1 + ((size_t)((bg * NKC + kc) * 64 + n2) * 2 + ri) * 128 + n1) = w;
                            if (jp == 0 || jp == 128) *(u32x2*)(A1 + ((size_t)((bg * NKC + kc) * 64 + n2) * 2 + 1) * 128 + n1) = (u32x2){0u, 0u};
                            __builtin_amdgcn_sched_barrier(0);
                        }
        } else if (kind == K_STAGE1) {
            bf16_t* A2 = (bf16_t*)(ws + WS_A2);
#pragma unroll
            for (int ai = 0; ai < 2; ++ai)
#pragma unroll
                for (int m = 0; m < 4; ++m) {
                    const int Rg = u.pm * 256 + ai * 128 + wr * 64 + m * 16 + 4 * fq, bgkc = Rg >> 6, n2 = Rg & 63, bg = bgkc / NKC, kc = bgkc - bg * NKC;
#pragma unroll
                    for (int n = 0; n < 2; ++n) {
                        const int k1 = wc * 32 + n * 16 + fr;
                        const f32x4 re = acc[ai][0][m][n], im = acc[ai][1][m][n]; f32x4 orr, oi;
#pragma unroll
                        for (int x = 0; x < 4; ++x) {
                            const float ph = (float)(((n2 + x) * k1) & 8191) * (1.0f / 8192.0f);
                            const float c = __builtin_amdgcn_cosf(ph), s = __builtin_amdgcn_sinf(ph);
                            orr[x] = re[x] * c + im[x] * s; oi[x] = im[x] * c - re[x] * s;
                        }
                        bf16_t* dst = A2 + ((size_t)((bg * 128 + k1) * NKC + kc) * 2) * 64 + n2;
                        u32x2 w0, w1; w0.x = cvt_pk_bf16(orr[0], orr[1]); w0.y = cvt_pk_bf16(orr[2], orr[3]); w1.x = cvt_pk_bf16(oi[0], oi[1]); w1.y = cvt_pk_bf16(oi[2], oi[3]);
                        *(u32x2*)dst = w0; *(u32x2*)(dst + 64) = w1;
                        __builtin_amdgcn_sched_barrier(0);
                    }
                }
        } else {
            LAS unsigned char* T = elds; bf16_t* YF = (bf16_t*)(ws + WS_YF);
            const int lane = fr + 16 * fq, W = wr * 4 + wc;
#pragma unroll
            for (int ai = 0; ai < 2; ++ai) {
                if (wc < 2) {
#pragma unroll
                    for (int m = 0; m < 4; ++m)
#pragma unroll
                        for (int n = 0; n < 2; ++n) { const int k2 = wc * 32 + n * 16 + fr; const f32x4 v = acc[ai][0][m][n];
                            u32x2 w; w.x = cvt_pk_bf16(v[0], v[1]); w.y = cvt_pk_bf16(v[2], v[3]);
                            *(LAS u32x2*)(T + k2 * 264 + (wr * 64 + m * 16 + 4 * fq) * 2) = w; }
                }
                LDS_WAIT(); __builtin_amdgcn_s_barrier(); asm volatile("" ::: "memory");
#pragma unroll
                for (int p2 = 0; p2 < 2; ++p2) {
                    const int rl = 64 * p2 + lane, Rg = u.pm * 256 + ai * 128 + rl, bg = Rg / (128 * NKC), rem = Rg - bg * (128 * NKC), k1 = rem / NKC, kc = rem - k1 * NKC;
                    const int b = bg >> 2, gr = bg & 3; const bool s1 = kc <= 128, s2 = kc >= 1 && kc <= 127;
#pragma unroll
                    for (int j = 0; j < 8; ++j) { const int k2 = 8 * W + j, k = k1 + 128 * k2;
                        const bf16_t o = *(const LAS bf16_t*)(T + k2 * 264 + rl * 2);
                        if (s1) YF[(size_t)(b * SEQ + k) * 1024 + gr * 256 + kc] = o;
                        if (s2) YF[(size_t)(b * SEQ + ((SEQ - k) & (SEQ - 1))) * 1024 + gr * 256 + 256 - kc] = o; }
                }
                LDS_WAIT(); __builtin_amdgcn_s_barrier(); asm volatile("" ::: "memory");
            }
        }
    }
};

namespace att {
constexpr int KSLOT = 16384, VSLOT = 32768, NSLOT = 3, NVSLOT = 3;
constexpr int NQR = 8;
constexpr int L_K = 0, L_V = NSLOT * KSLOT, L_Q = L_V + NVSLOT * VSLOT, QPAGE = (8 - NQR) * 1024, L_WS = L_Q + 8 * QPAGE;
__device__ __forceinline__ int crow(int r, int hi) { return (r & 3) + 8 * (r >> 2) + 4 * hi; }
#define SBAR() __builtin_amdgcn_sched_barrier(0)
__device__ __forceinline__ void glds16(const void* gbase, unsigned voff, unsigned lds_dst) { unsigned keep;
    asm volatile("s_mov_b32 %0, m0\n\ts_mov_b32 m0, %3\n\ts_nop 0\n\tglobal_load_lds_dwordx4 %1, %2\n\ts_mov_b32 m0, %0" : "=&s"(keep) : "v"(voff), "s"(gbase), "s"(lds_dst) : "memory"); }
template <int OFF> __device__ __forceinline__ s16x4 tr_read(int vb) {
    s16x4 r; asm volatile("ds_read_b64_tr_b16 %0, %1 offset:%2" : "=&v"(r) : "v"(vb), "i"(OFF) : "memory"); return r;
}
template <int D0, int KH> __device__ __forceinline__ void pvh_pair(f32x16& oa, f32x16& ob, int vb, bf16x8 pa, bf16x8 pb) {
    const s16x4 al0 = tr_read<D0 * 512 + (2 * KH) * 8192>(vb), ah0 = tr_read<D0 * 512 + (2 * KH) * 8192 + 4096>(vb), bl0 = tr_read<(D0 + 1) * 512 + (2 * KH) * 8192>(vb), bh0 = tr_read<(D0 + 1) * 512 + (2 * KH) * 8192 + 4096>(vb);
    const s16x4 al1 = tr_read<D0 * 512 + (2 * KH + 1) * 8192>(vb), ah1 = tr_read<D0 * 512 + (2 * KH + 1) * 8192 + 4096>(vb), bl1 = tr_read<(D0 + 1) * 512 + (2 * KH + 1) * 8192>(vb), bh1 = tr_read<(D0 + 1) * 512 + (2 * KH + 1) * 8192 + 4096>(vb);
    asm volatile("s_waitcnt lgkmcnt(0)" ::: "memory"); SBAR();
#define PKV(L, H) (bf16x8){L[0], L[1], L[2], L[3], H[0], H[1], H[2], H[3]}
    oa = __builtin_amdgcn_mfma_f32_32x32x16_bf16(pa, PKV(al0, ah0), oa, 0, 0, 0); ob = __builtin_amdgcn_mfma_f32_32x32x16_bf16(pa, PKV(bl0, bh0), ob, 0, 0, 0);
    oa = __builtin_amdgcn_mfma_f32_32x32x16_bf16(pb, PKV(al1, ah1), oa, 0, 0, 0); ob = __builtin_amdgcn_mfma_f32_32x32x16_bf16(pb, PKV(bl1, bh1), ob, 0, 0, 0);
#undef PKV
}
#define PV_RD(D0, KH, R) do { \
    R[0] = tr_read<(D0) * 512 + (2 * (KH)) * 8192>(vb); R[1] = tr_read<(D0) * 512 + (2 * (KH)) * 8192 + 4096>(vb); R[2] = tr_read<((D0) + 1) * 512 + (2 * (KH)) * 8192>(vb); R[3] = tr_read<((D0) + 1) * 512 + (2 * (KH)) * 8192 + 4096>(vb); \
    R[4] = tr_read<(D0) * 512 + (2 * (KH) + 1) * 8192>(vb); R[5] = tr_read<(D0) * 512 + (2 * (KH) + 1) * 8192 + 4096>(vb); R[6] = tr_read<((D0) + 1) * 512 + (2 * (KH) + 1) * 8192>(vb); R[7] = tr_read<((D0) + 1) * 512 + (2 * (KH) + 1) * 8192 + 4096>(vb); } while (0)
#define PV_MM(oa, ob, R) do { \
    oa = __builtin_amdgcn_mfma_f32_32x32x16_bf16(pa, (bf16x8){R[0][0], R[0][1], R[0][2], R[0][3], R[1][0], R[1][1], R[1][2], R[1][3]}, oa, 0, 0, 0); ob = __builtin_amdgcn_mfma_f32_32x32x16_bf16(pa, (bf16x8){R[2][0], R[2][1], R[2][2], R[2][3], R[3][0], R[3][1], R[3][2], R[3][3]}, ob, 0, 0, 0); \
    oa = __builtin_amdgcn_mfma_f32_32x32x16_bf16(pb, (bf16x8){R[4][0], R[4][1], R[4][2], R[4][3], R[5][0], R[5][1], R[5][2], R[5][3]}, oa, 0, 0, 0); ob = __builtin_amdgcn_mfma_f32_32x32x16_bf16(pb, (bf16x8){R[6][0], R[6][1], R[6][2], R[6][3], R[7][0], R[7][1], R[7][2], R[7][3]}, ob, 0, 0, 0); } while (0)
template <int KH> __device__ __forceinline__ void pv_half(f32x16 (&o)[8], int vb, bf16x8 pa, bf16x8 pb) {
    s16x4 ra[8], rb[8];
    PV_RD(0, KH, ra); PV_RD(2, KH, rb);
    asm volatile("s_waitcnt lgkmcnt(8)" ::: "memory"); SBAR(); PV_MM(o[0], o[1], ra); SBAR();
    PV_RD(4, KH, ra);
    asm volatile("s_waitcnt lgkmcnt(8)" ::: "memory"); SBAR(); PV_MM(o[2], o[3], rb); SBAR();
    PV_RD(6, KH, rb);
    asm volatile("s_waitcnt lgkmcnt(8)" ::: "memory"); SBAR(); PV_MM(o[4], o[5], ra); SBAR();
    asm volatile("s_waitcnt lgkmcnt(0)" ::: "memory"); SBAR(); PV_MM(o[6], o[7], rb);
}
#define KSWZ(row, colB) ((row) * 256 + ((colB) ^ (((row) & 15) << 4)))
#define PK4(Pv, BASE, OUT) do { unsigned a0 = cvt_pk_bf16(Pv[BASE + 0], Pv[BASE + 1]), a1 = cvt_pk_bf16(Pv[BASE + 2], Pv[BASE + 3]);   \
    unsigned b0_ = cvt_pk_bf16(Pv[BASE + 4], Pv[BASE + 5]), b1_ = cvt_pk_bf16(Pv[BASE + 6], Pv[BASE + 7]);                              \
    auto r0 = __builtin_amdgcn_permlane32_swap(a0, b0_, false, false); auto r1 = __builtin_amdgcn_permlane32_swap(a1, b1_, false, false); \
    u32x4 w = {r0[0], r1[0], r0[1], r1[1]}; OUT = __builtin_bit_cast(bf16x8, w); } while (0)

template <int KH> __device__ __forceinline__ void half_tile(f32x16 (&o)[8], float& lsum, const i32x8 (&q8)[2], int sclK, int sclQ, const LAS unsigned char* Ks, int vb, float dq, float nslope2, float negM2, int side, int r32, int hi) {
    f32x16 p;
    if (side != 0) {
        const float bsl = side > 0 ? -nslope2 : nslope2, a0 = __builtin_fmaf(-bsl, dq, negM2);
#pragma unroll
        for (int r = 0; r < 16; ++r) asm("v_fmamk_f32 %0, %1, %3, %2" : "=v"(p[r]) : "v"(bsl), "v"(a0), "i"(__builtin_bit_cast(int, (float)((r & 3) + 8 * (r >> 2) + 32 * KH))));
    } else {
#pragma unroll
        for (int r = 0; r < 16; ++r) { const float cr = (float)((r & 3) + 8 * (r >> 2) + 32 * KH); const float t0 = dq - cr;
            asm("v_fma_f32 %0, |%1|, %2, %3" : "=v"(p[r]) : "v"(t0), "s"(nslope2), "v"(negM2)); }
    }
    { const int sw = (r32 >> 1) & 7; const LAS unsigned char* kr = Ks + (32 * KH + r32) * 128;
      u32x4 kc[4];
#pragma unroll
      for (int m = 0; m < 2; ++m) { kc[2 * m] = *(const LAS u32x4*)(kr + (((4 * m + hi) ^ sw) * 16)); kc[2 * m + 1] = *(const LAS u32x4*)(kr + (((4 * m + 2 + hi) ^ sw) * 16)); }
#pragma unroll
      for (int m = 0; m < 2; ++m) { const i32x8 kf = {(int)kc[2 * m][0], (int)kc[2 * m][1], (int)kc[2 * m][2], (int)kc[2 * m][3], (int)kc[2 * m + 1][0], (int)kc[2 * m + 1][1], (int)kc[2 * m + 1][2], (int)kc[2 * m + 1][3]};
          p = __builtin_amdgcn_mfma_scale_f32_32x32x64_f8f6f4(kf, q8[m], p, 0, 0, 0, sclK, 0, sclQ); } }
    float ps = 0.f;
#pragma unroll
    for (int r = 0; r < 16; ++r) { p[r] = __builtin_amdgcn_exp2f(p[r]); ps += p[r]; }
    lsum += ps;
    bf16x8 pa, pb;
    PK4(p, 0, pa); PK4(p, 8, pb);
    pv_half<KH>(o, vb, pa, pb);
}

__device__ __forceinline__ void attn_pass(f32x16 (&o)[8], int b, int h, int c, int qb, int t_lo, int NT, float nslope2, float negM2,
                                          const unsigned char* __restrict__ Q, const unsigned char* __restrict__ K, const bf16_t* __restrict__ V, LAS unsigned char* lds, int wid0, int sclK, int sclQ) {
    int tid_ = wid0 * 64 + lane_id(); asm volatile("" : "+v"(tid_));
    const int tid = tid_, lane = tid & 63, r32 = lane & 31, hi = lane >> 5; const int wid = __builtin_amdgcn_readfirstlane(tid >> 6);
    const size_t rowbase = (size_t)b * SEQ;
    i32x8 q8[2];
    { const unsigned char* Qw = Q + (rowbase + qb * 256 + wid * 32 + r32) * DM + h * 256 + c * 128 + hi * 16;
#pragma unroll
      for (int m = 0; m < 2; ++m) { const u32x4 c0 = *(const u32x4*)(Qw + 64 * m), c1 = *(const u32x4*)(Qw + 64 * m + 32);
          q8[m] = (i32x8){(int)c0[0], (int)c0[1], (int)c0[2], (int)c0[3], (int)c1[0], (int)c1[1], (int)c1[2], (int)c1[3]}; }
      asm volatile("" :: "v"(q8[0]), "v"(q8[1]));
    }
    const unsigned char* Kh = K + (size_t)((b * 16 + h * 2 + c) * SEQ) * 128; const bf16_t* Vh = V + (size_t)((b * 16 + h * 2) * SEQ) * 128;
    unsigned kofs, vofs[4];
    { const int row_ = 8 * wid + (lane >> 3); kofs = (unsigned)(row_ * 128 + (((lane & 7) ^ ((row_ >> 1) & 7)) * 16)); }
#pragma unroll
    for (int i = 0; i < 4; ++i) { const int p_ = 4 * wid + i, kg_ = p_ >> 2, cb_ = 2 * (p_ & 3) + (lane >> 5), kk_ = kg_ * 8 + ((lane >> 2) & 7), key_ = (kk_ & ~0xC) | ((kk_ & 4) << 1) | ((kk_ & 8) >> 1);
        const int col_ = cb_ * 32 + (lane & 3) * 8; vofs[i] = (unsigned)((col_ >> 7) * (SEQ * 128 * 2) + key_ * 256 + (col_ & 127) * 2); }
    const unsigned lds0 = (unsigned)(uintptr_t)lds;
#define DMA_K(t) do { const unsigned char* kb_ = Kh + (size_t)(t_lo + (t)) * 64 * 128; const int sl_ = (t) % NSLOT; \
        glds16(kb_, kofs, (unsigned)__builtin_amdgcn_readfirstlane((int)(lds0 + L_K + sl_ * KSLOT + wid * 1024))); } while (0)
#define DMA_V(t) do { const bf16_t* vb_ = Vh + (size_t)(t_lo + (t)) * 64 * 128; const int sl_ = (t) % NVSLOT; \
        _Pragma("unroll") for (int _i = 0; _i < 4; ++_i) glds16(vb_, vofs[_i], (unsigned)__builtin_amdgcn_readfirstlane((int)(lds0 + L_V + sl_ * VSLOT + (4 * wid + _i) * 1024))); } while (0)
    const int vrd = ((lane & 3) << 3) | (((lane >> 2) & 3) << 6) | (((lane >> 4) & 1) << 5) | (((lane >> 5) & 1) << 8);
    const int vb0 = (int)(unsigned)(uintptr_t)(lds + L_V) + vrd;
#pragma unroll
    for (int d = 0; d < 8; ++d) o[d] = f32x16{};
    float lsum = 0.f;
    const int qw0 = qb * 256 + wid * 32;
    const int qpos = qw0 + r32 - 4 * hi;
    DMA_K(0); DMA_V(0); if (NT > 1) { DMA_K(1); DMA_V(1); }
    for (int j = 0; j < NT; ++j) {
        if (j + 1 < NT) asm volatile("s_waitcnt vmcnt(5)" ::: "memory"); else asm volatile("s_waitcnt vmcnt(0)" ::: "memory");
        __builtin_amdgcn_s_barrier(); asm volatile("" ::: "memory");
        const LAS unsigned char* Ks = lds + L_K + (j % NSLOT) * KSLOT; const int vb = vb0 + (j % NVSLOT) * VSLOT;
        const int kt0 = (t_lo + j) * 64, side = (kt0 + 63 < qw0) ? 1 : ((kt0 > qw0 + 31) ? -1 : 0);
        const float dq = (float)(qpos - kt0);
        half_tile<0>(o, lsum, q8, sclK, sclQ, Ks, vb, dq, nslope2, negM2, side, r32, hi);
        if (j + 2 < NT) { DMA_K(j + 2); DMA_V(j + 2); }
        half_tile<1>(o, lsum, q8, sclK, sclQ, Ks, vb, dq, nslope2, negM2, side, r32, hi);
    }
    LDS_WAIT(); __builtin_amdgcn_s_barrier(); asm volatile("" ::: "memory");
    { auto rr = __builtin_amdgcn_permlane32_swap(__float_as_uint(lsum), __float_as_uint(lsum), false, false); lsum = __uint_as_float(rr[0]) + __uint_as_float(rr[1]); }
    LAS float* wsf = (LAS float*)(lds + L_WS) + wid * 64;
    if (hi == 0) wsf[r32] = lsum; LDS_WAIT();
#pragma unroll
    for (int r = 0; r < 16; ++r) { const float rl = __builtin_amdgcn_rcpf(wsf[crow(r, hi)]);
#pragma unroll
        for (int d = 0; d < 8; ++d) o[d][r] *= rl; }
    LDS_WAIT();
#undef DMA_K
#undef DMA_V
}

__device__ __forceinline__ void attn_unit(int unit, const Ptrs& P, LAS unsigned char* lds, int lam_bits, int Mb_bits, int scl_bits) {
    int tid_ = P.wid0 * 64 + lane_id(); asm volatile("" : "+v"(tid_));
    const int tid = tid_, lane = tid & 63, r32 = lane & 31, hi = lane >> 5; const int wid = __builtin_amdgcn_readfirstlane(tid >> 6);
    const int qq = unit >> 6, uu = unit & 63;
    int b, hidx;
    if (qq < 6) { if ((uu >> 5) == 0) { b = qq & 1; hidx = 7 - (qq >> 1); } else { const int k2 = qq >> 1; hidx = 2 - k2; b = qq & 1; } }
    else { b = qq & 1; hidx = (uu >> 5) ? 3 : 4; }
    const int ii = uu & 31, qb = (ii & 1) ? 16 + (ii >> 1) : 15 - (ii >> 1);
    lam_bits = __builtin_amdgcn_readfirstlane(lam_bits); Mb_bits = __builtin_amdgcn_readfirstlane(Mb_bits);
    asm volatile("" : "+s"(lam_bits), "+s"(Mb_bits));
    const float lam = __int_as_float(lam_bits), Mb = __int_as_float(Mb_bits);
    const float slope = exp2f(-(float)(hidx + 1));
    int w = (int)ceilf((2.f * Mb + 104.f) / slope); if (w > SEQ) w = SEQ;
    const int klo = (qb * 256 - w) < 0 ? 0 : (qb * 256 - w), khi = (qb * 256 + 255 + w) > (SEQ - 1) ? (SEQ - 1) : (qb * 256 + 255 + w);
    const int t_lo = klo >> 6, NT = (khi >> 6) - t_lo + 1;
    const unsigned char* Q = P.ws + WS_Q8; const unsigned char* K = P.ws + WS_K; const bf16_t* V = (const bf16_t*)(P.ws + WS_V);
    const int sclQ = (scl_bits & 0xFF) * 0x01010101, sclK = ((scl_bits >> 8) & 0xFF) * 0x01010101;
    unsigned char* stash_b = (unsigned char*)P.out + (size_t)blockIdx.x * (32 * 8192);
#define STASH(i) ((f32x4*)(stash_b + (size_t)(i) * 8192 + st_))
    f32x16 o[8];
    attn_pass(o, b, hidx, 0, qb, t_lo, NT, -slope * LOG2E, -Mb * LOG2E, Q, K, V, lds, P.wid0, sclK, sclQ);
    { unsigned st_ = 16u * (unsigned)(P.wid0 * 64 + lane_id()); asm volatile("" : "+v"(st_));
#pragma unroll
      for (int d = 0; d < 8; ++d) {
#pragma unroll
          for (int r4 = 0; r4 < 4; ++r4) *STASH(d * 4 + r4) = (f32x4){o[d][r4 * 4], o[d][r4 * 4 + 1], o[d][r4 * 4 + 2], o[d][r4 * 4 + 3]};
          asm volatile("" : "+v"(st_)); } }
    attn_pass(o, b, hidx, 1, qb, t_lo, NT, -slope * LOG2E, -Mb * LOG2E, Q, K, V, lds, P.wid0, sclK, sclQ);
    float ss[16];
#pragma unroll
    for (int r = 0; r < 16; ++r) ss[r] = 0.f;
    { unsigned st_ = 16u * (unsigned)(P.wid0 * 64 + lane_id()); asm volatile("" : "+v"(st_));
#pragma unroll
      for (int d = 0; d < 8; ++d) {
#pragma unroll
          for (int r4 = 0; r4 < 4; ++r4) { const f32x4 s1 = *STASH(d * 4 + r4);
#pragma unroll
              for (int i = 0; i < 4; ++i) { const float x = s1[i] - lam * o[d][r4 * 4 + i]; o[d][r4 * 4 + i] = x; ss[r4 * 4 + i] += x * x; } }
          asm volatile("" : "+v"(st_) :: "memory");
      } }
#pragma unroll
    for (int r = 0; r < 16; ++r) {
#pragma unroll
        for (int off = 1; off < 32; off <<= 1) ss[r] += __shfl_xor(ss[r], off);
        ss[r] = (1.0f - LAM_INIT) / sqrtf(ss[r] * (1.0f / 256.0f) + EPS);
    }
    const float* sg = inptr(11);
    LAS bf16_t* stg = (LAS bf16_t*)(lds + wid * 16384);
#pragma unroll
    for (int d = 0; d < 8; ++d) { const float gcol = sg[d * 32 + r32];
#pragma unroll
        for (int r = 0; r < 16; ++r) stg[crow(r, hi) * 256 + d * 32 + r32] = (bf16_t)(cvt_pk_bf16(o[d][r] * ss[r] * gcol, 0.f) & 0xffffu); }
    LDS_WAIT(); asm volatile("" ::: "memory");
    bf16_t* Ow = (bf16_t*)(P.ws + WS_O) + ((size_t)b * SEQ + qb * 256 + wid * 32) * DM + hidx * 256;
#pragma unroll 4
    for (int i = 0; i < 16; ++i) { const int row = 2 * i + (lane >> 5), ch = lane & 31;
        const u32x4 v = *(const LAS u32x4*)(stg + row * 256 + ch * 8); *(u32x4*)(Ow + (size_t)row * DM + ch * 8) = v; }
    LDS_WAIT(); VM_WAIT();
#undef STASH
}
#undef PK4
#undef SBAR
#undef KSWZ
}

__device__ __forceinline__ unsigned f2bf(float f) { return cvt_pk_bf16(f, 0.f) & 0xffffu; }
struct P0Item { const float* W; bf16_t* WT; int K, N, item; };
__device__ __forceinline__ bool p0_item(const Ptrs& P, int it, P0Item& d) {
    constexpr int I_IN = (DM / 64) * (INW / 32), I_F = (1024 / 64) * (DM / 32), I_A = (DM / 64) * (DM / 32), I_O = I_A;
    unsigned char* ws = P.ws; int r = it;
    if (r < I_IN) { d = P0Item{inptr(2), (bf16_t*)(ws + WS_WTIN), DM, INW, r}; return true; } r -= I_IN;
    if (r < I_F) { d = P0Item{inptr(3), (bf16_t*)(ws + WS_WTF), 1024, DM, r}; return true; } r -= I_F;
    if (r < I_A) { d = P0Item{inptr(4), (bf16_t*)(ws + WS_WTA), DM, DM, r}; return true; } r -= I_A;
    if (r < I_O) { d = P0Item{inptr(12), (bf16_t*)(ws + WS_WTO), DM, DM, r}; return true; }
    return false;
}
__device__ __forceinline__ void p0_load(const P0Item& d, float (&v)[32], int lane) {
    const int nblk = d.N / 32, kb = d.item / nblk, nb = d.item % nblk, k0 = 64 * kb, n0 = 32 * nb;
#pragma unroll
    for (int i = 0; i < 32; ++i) { const int kk = 2 * i + (lane >> 5); v[i] = d.W[(size_t)(k0 + kk) * d.N + n0 + (lane & 31)]; }
}
__device__ __forceinline__ float p0_store(const P0Item& d, const float (&v)[32], LAS float* scr, int lane) {
    const int nblk = d.N / 32, kb = d.item / nblk, nb = d.item % nblk, k0 = 64 * kb, n0 = 32 * nb; float am = 0.f;
#pragma unroll
    for (int i = 0; i < 32; ++i) { const int kk = 2 * i + (lane >> 5); am = fmaxf(am, fabsf(v[i])); scr[kk * 33 + (lane & 31)] = v[i]; }
    LDS_WAIT(); asm volatile("" ::: "memory");
    const int c = lane & 7;
#pragma unroll
    for (int j = 0; j < 4; ++j) { const int n = (lane >> 3) + 8 * j; const LAS float* s = scr + (8 * c) * 33 + n;
        u32x4 o; o.x = cvt_pk_bf16(s[0 * 33], s[1 * 33]); o.y = cvt_pk_bf16(s[2 * 33], s[3 * 33]); o.z = cvt_pk_bf16(s[4 * 33], s[5 * 33]); o.w = cvt_pk_bf16(s[6 * 33], s[7 * 33]);
        *(u32x4*)(d.WT + (size_t)(n0 + n) * d.K + k0 + 8 * c) = o; }
    LDS_WAIT(); asm volatile("" ::: "memory");
    return am;
}
__device__ __forceinline__ void p0_prologue(const Ptrs& P, LAS unsigned char* lds) {
    int tid_ = P.wid0 * 64 + lane_id(); asm volatile("" : "+v"(tid_));
    const int tid = tid_, lane = tid & 63, wid = __builtin_amdgcn_readfirstlane(tid >> 6);
    const int gw = blockIdx.x * 8 + wid, NGW = gridDim.x * 8;
    LAS float* scr = (LAS float*)(lds + wid * 16384);
    unsigned char* ws = P.ws;
    { P0Item cur, nxt; float va[32], vb[32];
      bool has = p0_item(P, gw, cur);
      if (has) p0_load(cur, va, lane);
      for (int it = gw; has; it += 2 * NGW) {
          const bool h1 = p0_item(P, it + NGW, nxt);
          if (h1) p0_load(nxt, vb, lane);
          { const float am = p0_store(cur, va, scr, lane);
            if (cur.N == INW && (cur.item % (INW / 32)) * 32 >= 7168) { const float wm = wave_max(am); if (lane == 0) atomicMax((unsigned*)(ws + WS_CTL) + CW_GMAX, __float_as_uint(wm)); } }
          if (!h1) break;
          has = p0_item(P, it + 2 * NGW, cur);
          if (has) p0_load(cur, va, lane);
          { const float am = p0_store(nxt, vb, scr, lane);
            if (nxt.N == INW && (nxt.item % (INW / 32)) * 32 >= 7168) { const float wm = wave_max(am); if (lane == 0) atomicMax((unsigned*)(ws + WS_CTL) + CW_GMAX, __float_as_uint(wm)); } }
      } }
    const int gt = blockIdx.x * 512 + tid, NGT = gridDim.x * 512;
    { const float* wq = inptr(14); bf16_t* o = (bf16_t*)(ws + WS_WQ16);
      for (int i = gt; i < DM * DM / 8; i += NGT) { const f32x4 a = *(const f32x4*)(wq + (size_t)i * 8), b = *(const f32x4*)(wq + (size_t)i * 8 + 4); st8_bf16(o + (size_t)i * 8, a, b); } }
    { const float* sk = inptr(15); bf16_t* o = (bf16_t*)(ws + WS_SUBK);
      for (int i = gt; i < 8 * 256 * 256 / 8; i += NGT) { const int k8 = i & 31, r = (i >> 5) & 255, hh = i >> 13, c = r >> 7, key = r & 127, cp = (k8 * 8) >> 7, d = (k8 * 8) & 127;
          f32x4 a = {0.f, 0.f, 0.f, 0.f}, b = a;
          if (c == cp) { const float* s = sk + ((size_t)((hh * 2 + c) * 128 + key)) * 128 + d; a = *(const f32x4*)s; b = *(const f32x4*)(s + 4); }
          st8_bf16(o + (size_t)i * 8, a, b); } }
    { bf16_t* TT = (bf16_t*)(ws + WS_TT); bf16_t* F1 = (bf16_t*)(ws + WS_F1); bf16_t* F2 = (bf16_t*)(ws + WS_F2);
      for (int i = gt; i < 65536; i += NGT) {
          { const int jp = i >> 8, j = i & 255; float v;
            if (jp <= 128) v = __builtin_amdgcn_cosf((float)((j * jp) & 255) * (1.0f / 256.0f)); else v = -__builtin_amdgcn_sinf((float)((j * (jp - 128)) & 255) * (1.0f / 256.0f));
            TT[i] = (bf16_t)f2bf(v * (1.0f / 16.0f)); }
          { const int rr = i >> 8, cc = i & 255, rip = rr >> 7, k1 = rr & 127, ri = cc >> 7, n1 = cc & 127; const float ph = (float)((n1 * k1) & 127) * (1.0f / 128.0f);
            const float cs = __builtin_amdgcn_cosf(ph), sn = __builtin_amdgcn_sinf(ph);
            const float v = (rip == 0) ? (ri == 0 ? cs : sn) : (ri == 0 ? -sn : cs);
            F1[i] = (bf16_t)f2bf(v * 0.08838834764831845f); }
          if (i < 32768) { const int k2 = i >> 7, cc = i & 127, ri = cc >> 6, n2 = cc & 63; float v = 0.f;
            if (k2 < 64) { const float ph = (float)((n2 * k2) & 63) * (1.0f / 64.0f); v = (ri == 0 ? __builtin_amdgcn_cosf(ph) : __builtin_amdgcn_sinf(ph)) * 0.125f; }
            F2[i] = (bf16_t)f2bf(v); }
      } }
    { const float* g1 = inptr(1); f32x4 gv[8]; float gm = 0.f;
#pragma unroll
      for (int j = 0; j < 8; ++j) { gv[j] = *(const f32x4*)(g1 + (64 * j + lane) * 4); gm = fmaxf(gm, fmaxf(fmaxf(fabsf(gv[j][0]), fabsf(gv[j][1])), fmaxf(fabsf(gv[j][2]), fabsf(gv[j][3])))); }
      const float sx = exp2f((float)xn8_exp(wave_max(gm)));
      const float* X0 = inptr(0);
#define XN_LOAD(V, m) do { const f32x4* xr_ = (const f32x4*)(X0 + (size_t)(m) * DM) + lane; _Pragma("unroll") for (int j = 0; j < 8; ++j) V[j] = xr_[64 * j]; } while (0)
#define XN_STORE(V, m) do { float s_ = 0.f; _Pragma("unroll") for (int j = 0; j < 8; ++j) s_ += (V[j][0] * V[j][0] + V[j][1] * V[j][1]) + (V[j][2] * V[j][2] + V[j][3] * V[j][3]); \
          const float rstd_ = 1.0f / sqrtf(wave_sum(s_) * (1.0f / DM) + EPS); \
          u32x2* o8_ = (u32x2*)((bf16_t*)(ws + WS_XN) + (size_t)(m) * DM) + lane; \
          _Pragma("unroll") for (int j = 0; j < 8; ++j) { const f32x4 y = V[j] * rstd_ * gv[j]; u32x2 w; w.x = cvt_pk_bf16(y[0], y[1]); w.y = cvt_pk_bf16(y[2], y[3]); o8_[64 * j] = w; \
              int w8 = __builtin_amdgcn_cvt_pk_fp8_f32(y[0] * sx, y[1] * sx, 0, false); w8 = __builtin_amdgcn_cvt_pk_fp8_f32(y[2] * sx, y[3] * sx, w8, true); \
              ((unsigned*)(ws + WS_XN8 + (size_t)(m) * DM))[64 * j + lane] = (unsigned)w8; } } while (0)
      f32x4 xa[8], xb[8];
      if (gw < NTOK) XN_LOAD(xa, gw);
      for (int m = gw; m < NTOK; m += 2 * NGW) {
          const bool h1 = m + NGW < NTOK;
          if (h1) XN_LOAD(xb, m + NGW);
          XN_STORE(xa, m);
          if (!h1) break;
          if (m + 2 * NGW < NTOK) XN_LOAD(xa, m + 2 * NGW);
          XN_STORE(xb, m + NGW);
      }
#undef XN_LOAD
#undef XN_STORE
    }
}
typedef float f32x2 __attribute__((ext_vector_type(2)));
__device__ __forceinline__ void convert_experts(const Ptrs& P) {
    int tid_ = P.wid0 * 64 + lane_id(); asm volatile("" : "+v"(tid_));
    const int lane = tid_ & 63, wid = __builtin_amdgcn_readfirstlane(tid_ >> 6);
    const float* eu = inptr(16); const float* ev = inptr(17);
    unsigned char* ou = P.ws + WS_EU; unsigned char* ov = P.ws + WS_EV; float* esc = (float*)(P.ws + WS_ESC);
    unsigned* qh = (unsigned*)(P.ws + WS_CTL) + CW_CVTQ;
    for (;;) {
        unsigned c0 = 0u; if (lane == 0) c0 = atomicAdd(qh, 1u);
        const int chunk = __builtin_amdgcn_readfirstlane((int)c0);
        if (chunk >= 4096) break;
#define CV_LOAD(V, r) do { const int tbl_ = (r) >> 14, row_ = (r) & 16383; const float* s_ = (tbl_ ? ev : eu) + (size_t)row_ * DM + 32 * lane; _Pragma("unroll") for (int q = 0; q < 8; ++q) V[q] = *(const f32x4*)(s_ + 4 * q); } while (0)
#define CV_STORE(V, r) do { const int tbl = (r) >> 14, row = (r) & 16383; float am = 0.f; \
        _Pragma("unroll") for (int q = 0; q < 8; ++q) { _Pragma("unroll") for (int x = 0; x < 4; ++x) am = fmaxf(am, fabsf(V[q][x])); } \
        am = wave_max(am); \
        const float sc = am > 1e-30f ? 6.0f / am : 1.0f, inv = am > 1e-30f ? am * (1.0f / 6.0f) : 1.0f;        \
        u32x4 w; \
        _Pragma("unroll") for (int d = 0; d < 4; ++d) { unsigned t = 0u; const f32x4 a = V[2 * d] * sc, b = V[2 * d + 1] * sc; \
            t = __builtin_amdgcn_cvt_scalef32_pk_fp4_f32(t, a[0], a[1], 1.0f, 0); t = __builtin_amdgcn_cvt_scalef32_pk_fp4_f32(t, a[2], a[3], 1.0f, 1); \
            t = __builtin_amdgcn_cvt_scalef32_pk_fp4_f32(t, b[0], b[1], 1.0f, 2); t = __builtin_amdgcn_cvt_scalef32_pk_fp4_f32(t, b[2], b[3], 1.0f, 3); \
            w[d] = t; } \
        *(u32x4*)((tbl ? ov : ou) + (size_t)row * 1024 + 16 * lane) = w; \
        esc[tbl * 16384 + row] = inv; } while (0)
      { f32x4 va[8], vb[8]; const int r0 = chunk * 8;
        CV_LOAD(va, r0);
        CV_LOAD(vb, r0 + 1); CV_STORE(va, r0); CV_LOAD(va, r0 + 2); CV_STORE(vb, r0 + 1);
        CV_LOAD(vb, r0 + 3); CV_STORE(va, r0 + 2); CV_LOAD(va, r0 + 4); CV_STORE(vb, r0 + 3);
        CV_LOAD(vb, r0 + 5); CV_STORE(va, r0 + 4); CV_LOAD(va, r0 + 6); CV_STORE(vb, r0 + 5);
        CV_LOAD(vb, r0 + 7); CV_STORE(va, r0 + 6); CV_STORE(vb, r0 + 7); }
#undef CV_LOAD
#undef CV_STORE
    }
}

namespace peer {
__device__ __forceinline__ unsigned f2key(float f) { const unsigned u = __float_as_uint(f); return (u & 0x80000000u) ? ~u : (u | 0x80000000u); }
__device__ __forceinline__ float key2f(unsigned k) { const unsigned u = (k & 0x80000000u) ? (k & 0x7fffffffu) : ~k; return __uint_as_float(u); }
template <int CTRL> __device__ __forceinline__ unsigned dppu(unsigned x) { return (unsigned)__builtin_amdgcn_update_dpp(0, (int)x, CTRL, 0xF, 0xF, false); }
__device__ __forceinline__ unsigned umax_(unsigned a, unsigned b) { return a > b ? a : b; }
__device__ __forceinline__ unsigned rowmax16(unsigned x) {
    x = umax_(x, dppu<0xB1>(x)); x = umax_(x, dppu<0x4E>(x)); x = umax_(x, dppu<0x141>(x)); x = umax_(x, dppu<0x140>(x)); return x;
}
template <int CTRL, int RM> __device__ __forceinline__ float dpp_add(float v) { const int t = __builtin_amdgcn_update_dpp(0, __float_as_int(v), CTRL, RM, 0xF, true); return v + __int_as_float(t); }
__device__ __forceinline__ float wave_sum63(float v) {
    v = dpp_add<0x111, 0xF>(v); v = dpp_add<0x112, 0xF>(v); v = dpp_add<0x114, 0xF>(v); v = dpp_add<0x118, 0xF>(v);
    v = dpp_add<0x142, 0xA>(v); v = dpp_add<0x143, 0xC>(v); return v;
}
template <int CTRL, int RM> __device__ __forceinline__ float dpp_max0(float v) { const int t = __builtin_amdgcn_update_dpp(0, __float_as_int(v), CTRL, RM, 0xF, true); return fmaxf(v, __int_as_float(t)); }
__device__ __forceinline__ float wave_max63(float v) {
    v = dpp_max0<0x111, 0xF>(v); v = dpp_max0<0x112, 0xF>(v); v = dpp_max0<0x114, 0xF>(v); v = dpp_max0<0x118, 0xF>(v);
    v = dpp_max0<0x142, 0xA>(v); v = dpp_max0<0x143, 0xC>(v); return v;
}
__device__ __forceinline__ float gelu_erf(float v) { return 0.5f * v * (1.0f + erff(v * 0.70710678118654752f)); }

__device__ __forceinline__ void peer_phase(const Ptrs& P, LAS unsigned char* lds) {
    int tid_ = P.wid0 * 64 + lane_id(); asm volatile("" : "+v"(tid_));
    const int tid = tid_, lane0 = tid & 63, wid = __builtin_amdgcn_readfirstlane(tid >> 6);
    const int gw = blockIdx.x * 8 + wid, NGW = gridDim.x * 8;
    LAS int* pidx = (LAS int*)(lds + wid * 1024); LAS float* pgate = (LAS float*)(lds + wid * 1024 + 512);
    LAS unsigned char* xq = lds + 8192 + wid * 2048;
    const float* SC = (const float*)(P.ws + WS_SC); const unsigned char* EU = P.ws + WS_EU; const unsigned char* EV = P.ws + WS_EV; const float* ESC = (const float*)(P.ws + WS_ESC);
    const float* g2 = inptr(13); float* OUT = P.out;
    int cpk[4];
#pragma unroll
    for (int x = 0; x < 4; ++x) { const int sl = 4 * (lane0 & 15) + x; int v = 0, pre = 0;
        for (int i = 0; i < 16; ++i) { const int cnt = 16 / (i + 1); if (sl >= pre && sl < pre + cnt) v = i | ((sl - pre) << 4) | 256; pre += cnt; }
        cpk[x] = v; }
    for (int tok = gw; tok < NTOK; tok += NGW) {
        int lane = lane0; asm volatile("" : "+v"(lane));
        const int half = lane >> 5, li = lane & 31;
        float hres[32]; float rstd, xdq;
        { const float* hp = OUT + (size_t)tok * DM + lane; float s = 0.f;
#pragma unroll
          for (int q = 0; q < 32; ++q) hres[q] = __builtin_nontemporal_load(hp + 64 * q);
#pragma unroll
          for (int q = 0; q < 32; q += 4) s += (hres[q] * hres[q] + hres[q + 1] * hres[q + 1]) + (hres[q + 2] * hres[q + 2] + hres[q + 3] * hres[q + 3]);
          rstd = 1.0f / sqrtf(__int_as_float(__builtin_amdgcn_readlane(__float_as_int(wave_sum63(s)), 63)) * (1.0f / DM) + EPS);
          float hn[32], am = 0.f;
#pragma unroll
          for (int q = 0; q < 32; ++q) { hn[q] = hres[q] * rstd * g2[64 * q + lane]; am = fmaxf(am, fabsf(hn[q])); }
          am = __int_as_float(__builtin_amdgcn_readlane(__float_as_int(wave_max63(am)), 63));
          const float qs = am > 1e-30f ? 256.0f / am : 1.0f; xdq = am > 1e-30f ? am * (1.0f / 256.0f) : 1.0f;
#pragma unroll
          for (int q = 0; q < 32; ++q) { const int t = __builtin_amdgcn_cvt_pk_fp8_f32(hn[q] * qs, 0.f, 0, false); xq[64 * q + lane] = (unsigned char)(t & 0xFF); } }
        const int rho = lane >> 4, i16 = lane & 15, rbase = lane & 32;
#define CE(a, b) do { const unsigned hi_ = umax_(a, b), lo_ = (a) < (b) ? (a) : (b); a = hi_; b = lo_; } while (0)
        unsigned k[4][8], selA[4] = {0u, 0u, 0u, 0u};
#pragma unroll
        for (int q = 0; q < 4; ++q) {
            const float* sp = SC + (size_t)tok * DM + (2 * q + (rho >> 1)) * 256 + (rho & 1) * 128 + i16 * 8;
            const f32x4 s0 = __builtin_nontemporal_load((const f32x4*)sp), s1 = __builtin_nontemporal_load((const f32x4*)(sp + 4));
#pragma unroll
            for (int x = 0; x < 4; ++x) { k[q][x] = (f2key(s0[x]) & ~0x7Fu) | (unsigned)(127 - (i16 * 8 + x)); k[q][4 + x] = (f2key(s1[x]) & ~0x7Fu) | (unsigned)(127 - (i16 * 8 + 4 + x)); }
            CE(k[q][0], k[q][1]); CE(k[q][2], k[q][3]); CE(k[q][4], k[q][5]); CE(k[q][6], k[q][7]);
            CE(k[q][0], k[q][2]); CE(k[q][1], k[q][3]); CE(k[q][4], k[q][6]); CE(k[q][5], k[q][7]);
            CE(k[q][1], k[q][2]); CE(k[q][5], k[q][6]); CE(k[q][0], k[q][4]); CE(k[q][3], k[q][7]);
            CE(k[q][1], k[q][5]); CE(k[q][2], k[q][6]);
            CE(k[q][1], k[q][4]); CE(k[q][3], k[q][6]);
            CE(k[q][2], k[q][4]); CE(k[q][3], k[q][5]);
            CE(k[q][3], k[q][4]);
        }
#pragma unroll 1
        for (int r = 0; r < 16; ++r) {
#pragma unroll
            for (int q = 0; q < 4; ++q) {
                const unsigned m = rowmax16(k[q][0]);
                const bool hit = k[q][0] == m;
#pragma unroll
                for (int j = 0; j < 7; ++j) k[q][j] = hit ? k[q][j + 1] : k[q][j];
                k[q][7] = hit ? 0u : k[q][7];
                selA[q] = (i16 == r) ? m : selA[q];
            }
        }
        unsigned ck[4][4], selC[4] = {0u, 0u, 0u, 0u};
#pragma unroll
        for (int q = 0; q < 4; ++q) {
#pragma unroll
            for (int x = 0; x < 4; ++x) { const int ci = cpk[x] & 15, cj = (cpk[x] >> 4) & 15;
                const unsigned ka = (unsigned)__shfl((int)selA[q], rbase + ci), kb = (unsigned)__shfl((int)selA[q], rbase + 16 + cj);
                const float csum = key2f(ka & ~0x7Fu) + key2f(kb & ~0x7Fu);
                ck[q][x] = ((cpk[x] & 256) && (rho & 1) == 0) ? ((f2key(csum) & ~0xFFu) | (unsigned)(255 - (ci * 16 + cj))) : 0u; }
            CE(ck[q][0], ck[q][1]); CE(ck[q][2], ck[q][3]); CE(ck[q][0], ck[q][2]); CE(ck[q][1], ck[q][3]); CE(ck[q][1], ck[q][2]);
        }
#pragma unroll 1
        for (int r = 0; r < 16; ++r) {
#pragma unroll
            for (int q = 0; q < 4; ++q) {
                const unsigned m = rowmax16(ck[q][0]);
                const bool hit = ck[q][0] == m;
                ck[q][0] = hit ? ck[q][1] : ck[q][0]; ck[q][1] = hit ? ck[q][2] : ck[q][1]; ck[q][2] = hit ? ck[q][3] : ck[q][2]; ck[q][3] = hit ? 0u : ck[q][3];
                selC[q] = (i16 == r) ? m : selC[q];
            }
        }
#pragma unroll
        for (int q = 0; q < 4; ++q) {
            const int hh = 2 * q + (rho >> 1);
            const int flat = 255 - (int)(selC[q] & 0xFFu), fi = (flat >> 4) & 15, fj = flat & 15;
            const unsigned ea = (unsigned)__shfl((int)selA[q], rbase + fi), eb = (unsigned)__shfl((int)selA[q], rbase + 16 + fj);
            const int eidx = (127 - (int)(ea & 0x7Fu)) * 128 + (127 - (int)(eb & 0x7Fu));
            const float sv = key2f(selC[q] & ~0xFFu) * rstd;
            const float smax = __shfl(sv, rbase);
            const bool act_ = (rho & 1) == 0;
            float e = act_ ? __expf(sv - smax) : 0.f;
            float es = e; es += __shfl_xor(es, 1); es += __shfl_xor(es, 2); es += __shfl_xor(es, 4); es += __shfl_xor(es, 8);
            if (act_) { pidx[hh * 16 + i16] = eidx; pgate[hh * 16 + i16] = e / es; }
        }
#undef CE
        LDS_WAIT(); asm volatile("" ::: "memory");
        const int idxA = pidx[lane], idxB = pidx[64 + lane]; const float gA = pgate[lane], gB = pgate[64 + lane];
        LDS_WAIT(); asm volatile("" ::: "memory");
        const float uiA = ESC[idxA], uiB = ESC[idxB], viA = ESC[16384 + idxA], viB = ESC[16384 + idxB];
        float dA = 0.f, dB = 0.f;
        { const int c16 = lane & 15, g4 = lane >> 4;
          const unsigned xbo = (unsigned)(size_t)(xq + g4 * 16);
          const unsigned slot0 = (unsigned)__builtin_amdgcn_readfirstlane((int)(unsigned)(size_t)(lds + 24576 + wid * 16896));
          const unsigned aoffs = slot0 + (unsigned)((c16 & 7) * 1056 + (c16 >> 3) * 512 + g4 * 16);
          const unsigned dofs = (unsigned)(lane & 31) * 16u; const bool hi32 = (lane & 32) != 0;
          float WA_ = 0.f, WB_ = 0.f; int ridx = 0; f32x4 dcc = {0.f, 0.f, 0.f, 0.f};
#define STG(b, h) do { LDS_WAIT(); if ((h) == 0) ridx = pidx[16 * (b) + c16]; \
              _Pragma("unroll") for (int i_ = 0; i_ < 8; ++i_) { const int r0_ = __builtin_amdgcn_readlane(ridx, i_), r1_ = __builtin_amdgcn_readlane(ridx, i_ + 8); \
                  att::glds16(EU, (unsigned)(hi32 ? r1_ : r0_) * 1024u + (unsigned)(h) * 512u + dofs, slot0 + (h) * 8448 + i_ * 1056); } } while (0)
#define MMS(h) do { unsigned ao_ = aoffs + (h) * 8448, xo_ = xbo + (h) * 1024; asm volatile("" : "+v"(ao_), "+v"(xo_)); \
              _Pragma("unroll") for (int k_ = 0; k_ < 8; ++k_) { const u32x4 a_ = *(const LAS u32x4*)(ao_ + k_ * 64), b0_ = *(const LAS u32x4*)(xo_ + k_ * 128), b1_ = *(const LAS u32x4*)(xo_ + k_ * 128 + 64); \
                  const i32x8 bv_ = {(int)b0_[0], (int)b0_[1], (int)b0_[2], (int)b0_[3], (int)b1_[0], (int)b1_[1], (int)b1_[2], (int)b1_[3]}; \
                  const i32x8 av_ = {(int)a_[0], (int)a_[1], (int)a_[2], (int)a_[3], 0, 0, 0, 0}; \
                  dcc = __builtin_amdgcn_mfma_scale_f32_16x16x128_f8f6f4(av_, bv_, dcc, 4, 0, 0, 0x7F7F7F7F, 0, 0x7F7F7F7F); } } while (0)
#define EXTR(b) do { const float t_ = (c16 & 2) ? ((c16 & 1) ? dcc[3] : dcc[2]) : ((c16 & 1) ? dcc[1] : dcc[0]); \
              const bool m_ = (c16 >> 2) == ((b) & 3); WA_ = (m_ && (b) < 4) ? t_ : WA_; WB_ = (m_ && (b) >= 4) ? t_ : WB_; dcc = (f32x4){0.f, 0.f, 0.f, 0.f}; } while (0)
          STG(0, 0);
#pragma unroll 1
          for (int b = 0; b < 7; ++b) {
              STG(b, 1); asm volatile("s_waitcnt vmcnt(8)" ::: "memory"); MMS(0);
              STG(b + 1, 0); asm volatile("s_waitcnt vmcnt(8)" ::: "memory"); MMS(1); EXTR(b);
          }
          STG(7, 1); asm volatile("s_waitcnt vmcnt(8)" ::: "memory"); MMS(0);
          asm volatile("s_waitcnt vmcnt(0)" ::: "memory"); MMS(1); EXTR(7);
#undef STG
#undef MMS
#undef EXTR
          const int src = 16 * (c16 >> 2) + 4 * g4 + (lane & 3);
          dA = __shfl(WA_, src) * xdq; dB = __shfl(WB_, src) * xdq; }
        const float actA = gelu_erf(dA * uiA) * gA * viA, actB = gelu_erf(dB * uiB) * gB * viB;
        { const int c16 = lane & 15, g4 = lane >> 4;
          float amx = fmaxf(fabsf(actA), fabsf(actB)); amx = __int_as_float(__builtin_amdgcn_readlane(__float_as_int(wave_max63(amx)), 63));
          const float qa = amx > 1e-30f ? 256.0f / amx : 1.0f, adq = amx > 1e-30f ? amx * (1.0f / 256.0f) : 1.0f;
          LAS unsigned char* a8 = (LAS unsigned char*)pgate;
          { const int t8 = __builtin_amdgcn_cvt_pk_fp8_f32(actA * qa, actB * qa, 0, false); a8[lane] = (unsigned char)(t8 & 0xFF); a8[64 + lane] = (unsigned char)((t8 >> 8) & 0xFF); }
          LDS_WAIT(); asm volatile("" ::: "memory");
          const u32x4 a0_ = *(const LAS u32x4*)(a8 + 16 * g4), a1_ = *(const LAS u32x4*)(a8 + 64 + 16 * g4);
          const i32x8 av = {(int)a0_[0], (int)a0_[1], (int)a0_[2], (int)a0_[3], (int)a1_[0], (int)a1_[1], (int)a1_[2], (int)a1_[3]};
          unsigned rofs[8];
#pragma unroll
          for (int i = 0; i < 8; ++i) rofs[i] = (unsigned)pidx[16 * i + (lane >> 2)] * 1024u + (unsigned)(((lane & 3) ^ ((lane >> 4) & 3)) * 16);
          const unsigned slot0 = (unsigned)__builtin_amdgcn_readfirstlane((int)(unsigned)(size_t)(lds + 24576 + wid * 16896));
          unsigned ab[4];
#pragma unroll
          for (int c = 0; c < 4; ++c) ab[c] = slot0 + (unsigned)((32 * g4 + c16) * 64 + ((c ^ ((c16 >> 2) & 3)) * 16));
          float* orow = OUT + (size_t)tok * DM + lane;
#define DMAV(t) do { LDS_WAIT(); const unsigned char* vb_ = EV + (size_t)(t) * 64; const unsigned sl_ = slot0 + (unsigned)((t) & 1) * 8448u; \
              _Pragma("unroll") for (int i_ = 0; i_ < 8; ++i_) att::glds16(vb_, rofs[i_], sl_ + i_ * 1024); } while (0)
#define TR4(dst, a, OFF) asm volatile("ds_read_b64_tr_b4 %0, %1 offset:" #OFF : "=&v"(dst) : "v"(a) : "memory")
#define QUAD(c0, res) do { u32x2 r_[8]; \
              TR4(r_[0], ac[c0], 0); TR4(r_[1], ac[c0], 1024); TR4(r_[2], ac[c0], 8); TR4(r_[3], ac[c0], 1032); \
              TR4(r_[4], ac[c0 + 1], 0); TR4(r_[5], ac[c0 + 1], 1024); TR4(r_[6], ac[c0 + 1], 8); TR4(r_[7], ac[c0 + 1], 1032); \
              LDS_WAIT(); __builtin_amdgcn_sched_barrier(0); \
              _Pragma("unroll") for (int j_ = 0; j_ < 4; ++j_) { const i32x8 bv_ = {(int)r_[2 * j_][0], (int)r_[2 * j_][1], (int)r_[2 * j_ + 1][0], (int)r_[2 * j_ + 1][1], 0, 0, 0, 0}; \
                  const f32x4 z_ = {0.f, 0.f, 0.f, 0.f}; \
                  const f32x4 o_ = __builtin_amdgcn_mfma_scale_f32_16x16x128_f8f6f4(av, bv_, z_, 0, 4, 0, 0x7F7F7F7F, 0, 0x7F7F7F7F); \
                  const float s_ = (o_[0] + o_[1]) + (o_[2] + o_[3]);        \
                  res = (g4 == j_) ? s_ : res; } } while (0)
          float outv[32];
          DMAV(0);
#pragma unroll
          for (int t = 0; t < 16; ++t) {
              if (t < 15) { DMAV(t + 1); asm volatile("s_waitcnt vmcnt(8)" ::: "memory"); } else asm volatile("s_waitcnt vmcnt(0)" ::: "memory");
              unsigned ac[4]; const unsigned sb = (unsigned)(t & 1) * 8448u;
#pragma unroll
              for (int c = 0; c < 4; ++c) ac[c] = ab[c] + sb;
              float o0 = 0.f, o1 = 0.f;
              QUAD(0, o0); QUAD(2, o1);
              outv[2 * t] = o0; outv[2 * t + 1] = o1;
          }
#pragma unroll
          for (int q = 0; q < 32; ++q) __builtin_nontemporal_store(hres[q] + outv[q] * (0.25f * adq), orow + 64 * q);
#undef DMAV
#undef TR4
#undef QUAD
        }
        __builtin_amdgcn_sched_barrier(0);
    }
}
}

#define XB_TMO      128
#define XB_XCNT(j)  (256  + 64 * (j))
#define XB_XSUB(j)  (1280 + 64 * (j))
#define XB_XGEN(j)  (2304 + 64 * (j))
#define XB_TOP      3328
#define XB_TOPGEN   3392
#define XCD_BAR_WORDS 3456
#define XB_SPIN_CAP (1u << 24)
__device__ __forceinline__ unsigned xb_ld(unsigned* p)              { return __hip_atomic_load(p, __ATOMIC_RELAXED, __HIP_MEMORY_SCOPE_AGENT); }
__device__ __forceinline__ unsigned xb_add(unsigned* p, unsigned v) { return __hip_atomic_fetch_add(p, v, __ATOMIC_RELAXED, __HIP_MEMORY_SCOPE_AGENT); }
__device__ __forceinline__ unsigned xb_xcc_id() { return (unsigned)__builtin_amdgcn_s_getreg((3 << 11) | 20) & 0xFu; }
#define XB_SPIN(cond, bar) do { unsigned _sp = 0; while (cond) { __builtin_amdgcn_s_sleep(1); \
    if ((++_sp & 255u) == 0u) { if (xb_ld(&(bar)[XB_TMO])) break; if (_sp > XB_SPIN_CAP) { atomicAdd(&(bar)[XB_TMO], 1u); break; } } } } while (0)
struct XcdBarrier { unsigned* bar; unsigned x; volatile LAS unsigned* st; int wid0; };
__device__ __forceinline__ XcdBarrier xcd_barrier_post(unsigned* bar, volatile LAS unsigned* st, int wid0) {
    XcdBarrier b; b.bar = bar; b.x = xb_xcc_id(); b.st = st; b.wid0 = wid0;
    if (wid0 == 0 && lane_id() == 0) (void)xb_add(&bar[XB_XCNT(b.x)], 1u);
    return b;
}
__device__ __forceinline__ void xcd_barrier_complete(unsigned* bar, unsigned x, unsigned& nloc, unsigned& nx) {
    const unsigned G = gridDim.x * gridDim.y * gridDim.z;
    unsigned sum, cnt, mine, sp = 0u;
    for (;;) {
        sum = 0u; cnt = 0u; mine = 0u;
#pragma unroll
        for (unsigned j = 0; j < 16; ++j) { const unsigned c = xb_ld(&bar[XB_XCNT(j)]); sum += c; cnt += (c > 0u) ? 1u : 0u; mine = (j == x) ? c : mine; }
        if (sum == G) break;
        __builtin_amdgcn_s_sleep(1);
        if ((++sp & 255u) == 0u) { if (xb_ld(&bar[XB_TMO])) break; if (sp > XB_SPIN_CAP) { atomicAdd(&bar[XB_TMO], 1u); break; } }
    }
    nloc = mine > 0u ? mine : 1u; nx = cnt > 0u ? cnt : 1u;
}
__device__ __forceinline__ void xcd_barrier(const XcdBarrier& b) {
    asm volatile("s_waitcnt vmcnt(0)" ::: "memory");
    __syncthreads();
    if (b.wid0 == 0 && lane_id() == 0) {
        unsigned* bar = b.bar;
        __builtin_amdgcn_s_waitcnt(0);
        unsigned nloc = b.st[0], nx = b.st[1];
        if (nloc == 0u) { xcd_barrier_complete(bar, b.x, nloc, nx); b.st[0] = nloc; b.st[1] = nx; }
        const unsigned old = xb_add(&bar[XB_XSUB(b.x)], 1u);
        const unsigned gen = old / nloc;
        if (old + 1u == (gen + 1u) * nloc) {
            __builtin_amdgcn_fence(__ATOMIC_RELEASE, "agent");
            asm volatile("s_waitcnt vmcnt(0)" ::: "memory");
            const unsigned og = xb_add(&bar[XB_TOP], 1u);
            const unsigned tg = og / nx;
            if (og + 1u == (tg + 1u) * nx) xb_add(&bar[XB_TOPGEN], 1u);
            else XB_SPIN(xb_ld(&bar[XB_TOPGEN]) == tg, bar);
            __builtin_amdgcn_fence(__ATOMIC_ACQUIRE, "agent");
            xb_add(&bar[XB_XGEN(b.x)], 1u);
            asm volatile("s_waitcnt vmcnt(0)" ::: "memory");
        } else {
            XB_SPIN(xb_ld(&bar[XB_XGEN(b.x)]) == gen, bar);
            __builtin_amdgcn_fence(__ATOMIC_ACQUIRE, "agent");
            asm volatile("s_waitcnt vmcnt(0)" ::: "memory");
        }
    }
    __syncthreads();
}

struct KArgs { const float* in[18]; float* out; unsigned char* ws; int ph_lo, ph_hi; };
#ifndef DBG_NPH
#define DBG_NPH 9
#endif
constexpr int NPHASE = DBG_NPH;

__global__ void __launch_bounds__(512, 2) enc_fwd(KArgs args) {
    extern __shared__ __attribute__((aligned(16))) unsigned char lds_raw[];
    LAS unsigned char* lds = (LAS unsigned char*)lds_raw;
    const int lo = args.ph_lo, hi = args.ph_hi;
    if (hi > 1000) { __threadfence(); cg::this_grid().sync(); }
    Ptrs P; P.ws = args.ws; P.out = args.out; P.wid0 = __builtin_amdgcn_readfirstlane((int)threadIdx.x >> 6);
    const int G = gridDim.x, c = blockIdx.x;
    volatile LAS unsigned* bst = (volatile LAS unsigned*)(lds + LDS_BYTES - 64);
    if (P.wid0 == 0 && lane_id() == 0) { bst[0] = 0u; bst[1] = 0u; }
    __syncthreads();
    XcdBarrier xbar; xbar.bar = (unsigned*)(P.ws + WS_CTL) + CW_BAR; xbar.x = 0; xbar.st = bst; xbar.wid0 = P.wid0;
    if (hi - lo > 2) xbar = xcd_barrier_post((unsigned*)(P.ws + WS_CTL) + CW_BAR, bst, P.wid0);
#ifndef PHASE_MASK
#define PHASE_MASK 0x1ff
#endif
#define IN(k) (((PHASE_MASK >> (k)) & 1) && lo <= (k) && (k) < hi)
#define SEAM(k) do { if (lo <= (k) && (k) + 1 < hi) xcd_barrier(xbar); } while (0)
#define RUN_RM(KIND) do { Sched<KIND> S{G, c, P.ws}; EpiRM<KIND> E{P, 0.f}; g8::gemm_phase<EpiRM<KIND>, Sched<KIND>>(lds, geo_of(KIND), S, E, P.wid0); } while (0)
#define RUN_T(KIND) do { Sched<KIND> S{G, c, P.ws}; EpiT<KIND> E{P, 0.f}; g8::gemm_phase<EpiT<KIND>, Sched<KIND>>(lds, geo_of(KIND), S, E, P.wid0); } while (0)
    if (IN(0)) p0_prologue(P, lds);
    SEAM(0);
    if (IN(1)) {
        { int tid_ = P.wid0 * 64 + lane_id(); asm volatile("" : "+v"(tid_));
          const float sw = exp2f((float)wg8_exp(((const unsigned*)(P.ws + WS_CTL))[CW_GMAX]));
          const bf16_t* src = (const bf16_t*)(P.ws + WS_WTIN) + (size_t)7168 * DM; unsigned char* dst = P.ws + WS_WG8;
          for (int i = blockIdx.x * 512 + tid_; i < 4096 * DM / 8; i += gridDim.x * 512) { f32x4 a, b; ld8_bf16(src + (size_t)i * 8, a, b);
              int w0 = __builtin_amdgcn_cvt_pk_fp8_f32(a[0] * sw, a[1] * sw, 0, false); w0 = __builtin_amdgcn_cvt_pk_fp8_f32(a[2] * sw, a[3] * sw, w0, true);
              int w1 = __builtin_amdgcn_cvt_pk_fp8_f32(b[0] * sw, b[1] * sw, 0, false); w1 = __builtin_amdgcn_cvt_pk_fp8_f32(b[2] * sw, b[3] * sw, w1, true);
              *(u32x2*)(dst + (size_t)i * 8) = (u32x2){(unsigned)w0, (unsigned)w1}; } }
        RUN_RM(K_INPROJ); }
    SEAM(1);
    if (IN(2)) {
        { const int lane = lane_id(); const float* g1 = inptr(1); float gm = 0.f;
          for (int i = lane; i < DM; i += 64) gm = fmaxf(gm, fabsf(g1[i]));
          int fsc_bits = __builtin_amdgcn_readfirstlane(__float_as_int(exp2f(-(float)(xn8_exp(wave_max(gm)) + wg8_exp(((const unsigned*)(P.ws + WS_CTL))[CW_GMAX])))));
          asm volatile("" : "+s"(fsc_bits));
          Sched<K_GATE8> S{G, c, P.ws}; EpiRM<K_GATE8> E{P, __int_as_float(fsc_bits)}; g8::gemm_phase<EpiRM<K_GATE8>, Sched<K_GATE8>>(lds, geo_of(K_GATE8), S, E, P.wid0); }
        VM_WAIT(); __syncthreads();
        RUN_T(K_STEPA); }
    SEAM(2);
    if (IN(3)) { RUN_T(K_STAGE1); VM_WAIT(); __syncthreads();
        { Sched<K_FOLD> S{G, (c + G - 64) % G, P.ws}; EpiRM<K_FOLD> E{P, 0.f}; g8::gemm_phase<EpiRM<K_FOLD>, Sched<K_FOLD>>(lds, geo_of(K_FOLD), S, E, P.wid0); } }
    SEAM(3);
    if (IN(4)) {
#ifndef DBG_NO_ST2
        RUN_T(K_STAGE2); VM_WAIT(); __syncthreads();
#endif
        const int lane = lane_id();
        const float s1 = wave_sum(inptr(7)[lane] * inptr(8)[lane] + inptr(7)[lane + 64] * inptr(8)[lane + 64]);
        const float s2 = wave_sum(inptr(9)[lane] * inptr(10)[lane] + inptr(9)[lane + 64] * inptr(10)[lane + 64]);
        const int lam_bits = __builtin_amdgcn_readfirstlane(__float_as_int(__expf(s1) - __expf(s2) + LAM_INIT));
        const float mq = wave_max(fmaxf(fabsf(inptr(5)[lane]), fabsf(inptr(5)[lane + 64]))), mk = wave_max(fmaxf(fabsf(inptr(6)[lane]), fabsf(inptr(6)[lane + 64])));
        const int Mb_bits = __builtin_amdgcn_readfirstlane(__float_as_int(11.313708498984761f * mq * mk * 1.15f));
        const int scl_bits = __builtin_amdgcn_readfirstlane(((127 - fp8_exp(mq, 0.08838834764831845f * LOG2E)) & 0xFF) | (((127 - fp8_exp(mk, 1.0f)) & 0xFF) << 8));
        unsigned* qhead = (unsigned*)(P.ws + WS_CTL) + CW_ATTQ;
        LAS int* ubox = (LAS int*)(lds + att::L_WS + 2048 - 16);
        const int xcc = (int)(xb_xcc_id() & 7u);
#ifndef DBG_NO_ATT
        for (int dq_ = 0; dq_ < 8; ++dq_) {
            const int q = (xcc + dq_) & 7;
            for (;;) {
                if (P.wid0 == 0 && lane == 0) ubox[0] = (int)atomicAdd(qhead + 64 * q, 1u);
                __syncthreads();
                const int u = __builtin_amdgcn_readfirstlane(ubox[0]);
                __syncthreads();
                if (u >= 64) break;
                att::attn_unit(q * 64 + u, P, lds, lam_bits, Mb_bits, scl_bits);
            }
        }
#endif
        convert_experts(P);
    }
    SEAM(4);
    if (IN(5)) { RUN_RM(K_YA); VM_WAIT(); __syncthreads(); RUN_RM(K_YF); }
    SEAM(5);
    if (IN(6)) RUN_RM(K_OUT);
    SEAM(6);
    if (IN(7)) RUN_RM(K_SC);
    SEAM(7);
    if (IN(8)) peer::peer_phase(P, lds);
}

extern "C" void kernel_launch(void* const* d_in, const int* in_sizes, int n_in, void* d_out, int out_size, void* d_ws, size_t ws_size, hipStream_t stream) {
    static int grid = 0;
    if (grid == 0) {
        if (n_in != 18 || in_sizes[0] != NTOK * DM || out_size != NTOK * DM || ws_size < WS_END) {
            fprintf(stderr, "kernel_launch: shape mismatch (n_in %d, in0 %d, out %d, ws %zu)\n", n_in, n_in > 0 ? in_sizes[0] : -1, out_size, ws_size); grid = -1; return; }
        int dev = 0, cus = 0, per_cu = 0;
        hipGetDevice(&dev); hipDeviceGetAttribute(&cus, hipDeviceAttributeMultiprocessorCount, dev);
        if (hipFuncSetAttribute((const void*)enc_fwd, hipFuncAttributeMaxDynamicSharedMemorySize, LDS_BYTES) != hipSuccess) { fprintf(stderr, "kernel_launch: hipFuncSetAttribute failed\n"); grid = -1; return; }
        if (hipOccupancyMaxActiveBlocksPerMultiprocessor(&per_cu, (const void*)enc_fwd, 512, LDS_BYTES) != hipSuccess || per_cu < 1) { fprintf(stderr, "kernel_launch: occupancy query gives %d\n", per_cu); per_cu = 1; }
        (void)hipGetLastError();
        grid = cus;
    }
    if (grid < 0) return;
    hipMemsetAsync((char*)d_ws + WS_CTL, 0, CTL_BYTES, stream);
    KArgs a{};
    for (int i = 0; i < 18; ++i) a.in[i] = (const float*)d_in[i];
    a.out = (float*)d_out; a.ws = (unsigned char*)d_ws;
#if MK_ONE_LAUNCH
    a.ph_lo = 0; a.ph_hi = NPHASE;
    void* kargs[] = {&a};
    hipError_t e = hipLaunchCooperativeKernel((const void*)enc_fwd, dim3(grid), dim3(512), kargs, LDS_BYTES, stream);
    if (e != hipSuccess) fprintf(stderr, "cooperative launch failed: %s (grid %d)\n", hipGetErrorString(e), grid);
#else
#ifndef DBG_SEQ
#define DBG_SEQ "012345678"
#endif
    const char* seq = DBG_SEQ;
    for (int i = 0; seq[i]; ++i) {
        const int ph = seq[i] - '0';
        if (ph == 4) hipMemsetAsync((char*)d_ws + WS_CTL, 0, CTL_BYTES, stream);
        a.ph_lo = ph; a.ph_hi = ph + 1;
        hipLaunchKernelGGL(enc_fwd, dim3(grid), dim3(512), LDS_BYTES, stream, a);
    }
    const hipError_t le = hipPeekAtLastError();
    if (le != hipSuccess) fprintf(stderr, "kernel_launch: launch failed: %s\n", hipGetErrorName(le));
#endif
}
```
